# Optimizing an MI355X kernel written in HIP

```python
import jax, jax.numpy as jnp
from jax import lax
import numpy as np

D_MODEL = 1024
BATCH = 8
SEQ = 4096
DEPTH = 1

CHUNK = 64
D_MIX = D_MODEL
SB_WIDTH = D_MIX // 2
SB_HEADS = 8
SB_HEAD_DIM = SB_WIDTH // SB_HEADS
SB_BLOCK = 128
HG_WIDTH = D_MIX - SB_WIDTH
HG_EXPAND = 128
HG_HEADS = HG_WIDTH // HG_EXPAND
PLE_DIM = 256
N_GROUPS = 4
EXPERTS_PER_GROUP = 8
N_EXPERTS = N_GROUPS * EXPERTS_PER_GROUP
TOP_K = 2
D_EXPERT = D_MODEL // 2
EPS = 1e-6
IN_COLS = 3 * SB_WIDTH + 4 * HG_WIDTH

kernel_name = "hymba_sb_hgrn2_hmoe_ple"


def rmsnorm(x, w):
    xf = x.astype(jnp.float32)
    y = xf * lax.rsqrt(jnp.mean(xf * xf, axis=-1, keepdims=True) + EPS)
    return (y * w.astype(jnp.float32)).astype(x.dtype)


def head_rmsnorm(x, w):
    h, dh = x.shape[-2], x.shape[-1]
    y = x * lax.rsqrt(jnp.mean(x * x, axis=-1, keepdims=True) + EPS)
    return y * w.astype(jnp.float32).reshape(h, dh)


def stick_breaking_attention(q, k, v):
    s_len, dh = q.shape[2], q.shape[3]
    scale = dh ** -0.5
    outs = []
    for blk in range(s_len // SB_BLOCK):
        q0 = blk * SB_BLOCK
        q1 = q0 + SB_BLOCK
        qb = q[:, :, q0:q1]
        kb = k[:, :, :q1]
        vb = v[:, :, :q1]
        z = jnp.einsum('bhtd,bhsd->bhts', qb, kb) * scale
        t_pos = q0 + jnp.arange(SB_BLOCK)[:, None]
        s_pos = jnp.arange(q1)[None, :]
        before = s_pos < t_pos
        log_keep = jnp.where(before, jax.nn.log_sigmoid(-z), 0.0)
        between = lax.cumsum(log_keep, axis=3, reverse=True) - log_keep
        log_a = jax.nn.log_sigmoid(z) + between
        a = jnp.where(before, jnp.exp(log_a), 0.0)
        outs.append(jnp.einsum('bhts,bhsd->bhtd', a, vb))
    return jnp.concatenate(outs, axis=2)


def hgrn2_chunkwise(q, k, v, log_f):
    b, h, s_len, dk = q.shape
    dv = v.shape[-1]
    n = s_len // CHUNK

    def to_chunks(t):
        return jnp.moveaxis(t.reshape(b, h, n, CHUNK, t.shape[-1]), 2, 0)

    causal = jnp.tril(jnp.ones((CHUNK, CHUNK), dtype=bool))

    def step(state, inp):
        qc, kc, vc, gc = inp
        bc = jnp.cumsum(gc, axis=2)
        diff = bc[:, :, :, None, :] - bc[:, :, None, :, :]
        decay = jnp.exp(jnp.where(causal[:, :, None], diff, -jnp.inf))
        scores = jnp.einsum('bhtk,bhsk,bhtsk->bhts', qc, kc, decay)
        o = (jnp.einsum('bhts,bhsv->bhtv', scores, vc)
             + jnp.einsum('bhtk,bhkv->bhtv', qc * jnp.exp(bc), state))
        b_last = bc[:, :, -1:, :]
        new_state = (jnp.exp(b_last[:, :, 0, :, None]) * state
                     + jnp.einsum('bhsk,bhsv->bhkv', kc * jnp.exp(b_last - bc), vc))
        return new_state, o

    s0 = jnp.zeros((b, h, dk, dv), q.dtype)
    _, o = lax.scan(step, s0, (to_chunks(q), to_chunks(k), to_chunks(v), to_chunks(log_f)))
    return jnp.moveaxis(o, 0, 2).reshape(b, h, s_len, dv)


def hierarchical_moe(x, w_group_router, b_group_router, w_expert_router, b_expert_router,
                     w_gate, w_up, w_down):
    bsz, s_len, d = x.shape
    xt = x.reshape(-1, d)
    n = xt.shape[0]
    xf = xt.astype(jnp.float32)
    group_logits = xf @ w_group_router.astype(jnp.float32) + b_group_router.astype(jnp.float32)
    group_probs = jax.nn.softmax(group_logits, axis=-1)
    g_idx = jnp.argmax(group_logits, axis=-1).astype(jnp.int32)
    g_prob = jnp.take_along_axis(group_probs, g_idx[:, None], axis=1)
    expert_logits = (xf @ w_expert_router.astype(jnp.float32)
                     + b_expert_router.astype(jnp.float32)).reshape(n, N_GROUPS, EXPERTS_PER_GROUP)
    in_group = jnp.take_along_axis(expert_logits, g_idx[:, None, None], axis=1)[:, 0]
    top_vals, top_idx = lax.top_k(in_group, TOP_K)
    gates = jax.nn.softmax(top_vals, axis=-1) * g_prob
    expert_ids = (g_idx[:, None] * EXPERTS_PER_GROUP + top_idx.astype(jnp.int32)).reshape(-1)
    order = jnp.argsort(expert_ids)
    token_ids = order // TOP_K
    group_sizes = jnp.bincount(expert_ids, length=N_EXPERTS).astype(jnp.int32)
    xs = xt[token_ids]
    hg = lax.ragged_dot(xs, w_gate.astype(xs.dtype), group_sizes)
    hu = lax.ragged_dot(xs, w_up.astype(xs.dtype), group_sizes)
    y = lax.ragged_dot(jax.nn.silu(hg) * hu, w_down.astype(xs.dtype), group_sizes)
    y = y * gates.reshape(-1)[order][:, None].astype(y.dtype)
    out = jnp.zeros_like(xt).at[token_ids].add(y.astype(xt.dtype))
    return out.reshape(bsz, s_len, d)


def setup_inputs(seed: int = 0) -> dict:
    key = jax.random.key(seed)
    ks = jax.random.split(key, 20)
    f32 = jnp.float32

    def nrm(k, shape, scale):
        return jax.random.normal(k, shape, f32) * scale

    def gain(k, shape):
        return 1.0 + 0.01 * jax.random.normal(k, shape, f32)

    return {
        "x": nrm(ks[0], (BATCH, SEQ, D_MODEL), 1.0),
        "p": nrm(ks[1], (DEPTH, BATCH, SEQ, PLE_DIM), 1.0),
        "attn_norm_w": gain(ks[2], (DEPTH, D_MODEL)),
        "w_in": nrm(ks[3], (DEPTH, D_MODEL, IN_COLS), D_MODEL ** -0.5),
        "sb_norm_w": gain(ks[4], (DEPTH, SB_WIDTH)),
        "hg_lower_bounds": nrm(ks[5], (DEPTH + 1, HG_WIDTH), 0.5),
        "hg_norm_w": gain(ks[6], (DEPTH, HG_WIDTH)),
        "w_out": nrm(ks[7], (DEPTH, D_MIX, D_MODEL), D_MIX ** -0.5),
        "ffn_norm_w": gain(ks[8], (DEPTH, D_MODEL)),
        "w_group_router": nrm(ks[9], (DEPTH, D_MODEL, N_GROUPS), D_MODEL ** -0.5),
        "b_group_router": nrm(ks[10], (DEPTH, N_GROUPS), 0.01),
        "w_expert_router": nrm(ks[11], (DEPTH, D_MODEL, N_EXPERTS), D_MODEL ** -0.5),
        "b_expert_router": nrm(ks[12], (DEPTH, N_EXPERTS), 0.01),
        "w_exp_gate": nrm(ks[13], (DEPTH, N_EXPERTS, D_MODEL, D_EXPERT), D_MODEL ** -0.5),
        "w_exp_up": nrm(ks[14], (DEPTH, N_EXPERTS, D_MODEL, D_EXPERT), D_MODEL ** -0.5),
        "w_exp_down": nrm(ks[15], (DEPTH, N_EXPERTS, D_EXPERT, D_MODEL), D_EXPERT ** -0.5),
        "ple_norm_w": gain(ks[16], (DEPTH, D_MODEL)),
        "w_ple_proj": nrm(ks[17], (DEPTH, PLE_DIM, D_MODEL), PLE_DIM ** -0.5),
        "w_ple_gate": nrm(ks[18], (DEPTH, D_MODEL, D_MODEL), D_MODEL ** -0.5),
        "final_norm_w": gain(ks[19], (D_MODEL,)),
    }


def reference(x, p, attn_norm_w, w_in, sb_norm_w, hg_lower_bounds, hg_norm_w, w_out,
              ffn_norm_w, w_group_router, b_group_router, w_expert_router, b_expert_router,
              w_exp_gate, w_exp_up, w_exp_down, ple_norm_w, w_ple_proj, w_ple_gate,
              final_norm_w):
    f32 = jnp.float32
    bsz, s_len, _ = x.shape
    lower_bounds = jnp.cumsum(jax.nn.softmax(hg_lower_bounds.astype(f32), axis=0), axis=0)
    h = x
    for i in range(DEPTH):
        a = rmsnorm(h, attn_norm_w[i])
        proj = (a @ w_in[i]).astype(f32)
        sb_q, sb_k, sb_v, hg_q, hg_f, hg_i, hg_g = jnp.split(
            proj, np.cumsum([SB_WIDTH] * 3 + [HG_WIDTH] * 3).tolist(), axis=-1)

        def sb_heads(t):
            return t.reshape(bsz, s_len, SB_HEADS, SB_HEAD_DIM).transpose(0, 2, 1, 3)

        sb_o = stick_breaking_attention(sb_heads(sb_q), sb_heads(sb_k), sb_heads(sb_v))
        sb_o = head_rmsnorm(sb_o.transpose(0, 2, 1, 3), sb_norm_w[i])
        sb_o = sb_o.reshape(bsz, s_len, SB_WIDTH)

        lb = lower_bounds[i]
        f = lb + (1.0 - lb) * jax.nn.sigmoid(hg_f)
        log_f = jnp.log(f)
        hk = 1.0 - f

        def hg_heads(t):
            return t.reshape(bsz, s_len, HG_HEADS, HG_EXPAND).transpose(0, 2, 1, 3)

        hg_o = hgrn2_chunkwise(hg_heads(jax.nn.silu(hg_q)), hg_heads(hk),
                               hg_heads(hg_i), hg_heads(log_f))
        hg_o = head_rmsnorm(hg_o.transpose(0, 2, 1, 3), hg_norm_w[i]).reshape(bsz, s_len, HG_WIDTH)
        hg_o = hg_o * jax.nn.silu(hg_g)

        mix = jnp.concatenate([sb_o, hg_o], axis=-1).astype(h.dtype)
        h = h + (mix @ w_out[i]).astype(h.dtype)

        m = rmsnorm(h, ffn_norm_w[i])
        h = h + hierarchical_moe(m, w_group_router[i], b_group_router[i], w_expert_router[i],
                                 b_expert_router[i], w_exp_gate[i], w_exp_up[i],
                                 w_exp_down[i]).astype(h.dtype)

        e = (p[i].astype(h.dtype) @ w_ple_proj[i]).astype(f32)
        gate = jax.nn.sigmoid((rmsnorm(h, ple_norm_w[i]) @ w_ple_gate[i]).astype(f32))
        h = h + (gate * e).astype(h.dtype)
    return rmsnorm(h, final_norm_w)
```

```cpp
#include <hip/hip_runtime.h>
#include <cstdio>
#include <cstdint>

#ifndef FUSED
#define FUSED 0
#endif

constexpr int BATCH = 8, SEQ = 4096, DM = 1024, M = BATCH * SEQ;
constexpr int SBW = 512, SBH = 8, SBD = 64;
constexpr int HGW = 512, HGH = 4, HGD = 128;
constexpr int PLE = 256, NG = 4, EPG = 8, NE = 32, DE = 512, INC = 3584;
constexpr float EPS = 1e-6f;
constexpr int NT = 512;

typedef unsigned short bf16;
__device__ __forceinline__ bf16 f2bf(float f) { unsigned u = __float_as_uint(f); return (bf16)((u + 0x7fffu + ((u >> 16) & 1u)) >> 16); }
__device__ __forceinline__ float bf2f(bf16 h) { return __uint_as_float(((unsigned)h) << 16); }
__device__ __forceinline__ float bflo(unsigned w) { return __uint_as_float(w << 16); }
__device__ __forceinline__ float bfhi(unsigned w) { return __uint_as_float(w & 0xffff0000u); }
__device__ __forceinline__ unsigned pk2(float lo, float hi) { return (unsigned)f2bf(lo) | ((unsigned)f2bf(hi) << 16); }
__device__ __forceinline__ float wave_sum(float v) {
#pragma unroll
    for (int o = 1; o < 64; o <<= 1) v += __shfl_xor(v, o);
    return v;
}
__device__ __forceinline__ float sigmoidf_(float x) { return 1.0f / (1.0f + expf(-x)); }

constexpr size_t MiB = 1u << 20;
constexpr size_t WS_CTL = 0;
constexpr size_t WS_LB = 1 * MiB;
constexpr size_t WS_RSTD1 = 1 * MiB + 64 * 1024;
constexpr size_t WS_RSTD2 = 1 * MiB + 256 * 1024;
constexpr size_t WS_TOKE = 2 * MiB;
constexpr size_t WS_TOKR = 2 * MiB + 512 * 1024;
constexpr size_t WS_GATE = 3 * MiB;
constexpr size_t WS_LIST = 4 * MiB;
constexpr size_t WS_WBF = 8 * MiB;
constexpr size_t WS_PB = 116 * MiB;
constexpr size_t WS_XN = 132 * MiB;
constexpr size_t WS_MIX = 132 * MiB;
constexpr size_t WS_H2B = 132 * MiB;
constexpr size_t WS_SBQ = 196 * MiB, WS_SBK = 228 * MiB, WS_SBV = 260 * MiB;
constexpr size_t WS_HQ = 292 * MiB, WS_HK = 324 * MiB, WS_HV = 356 * MiB, WS_HGATE = 388 * MiB;
constexpr size_t WS_LOGF = 420 * MiB;
constexpr size_t WS_H1B = 196 * MiB;
constexpr size_t WS_ACT = 260 * MiB;
constexpr size_t WS_Y = 324 * MiB;
constexpr size_t WS_END = 484 * MiB;
constexpr int CW_CNT = 64;

struct P {
    const float *x, *p, *attn_w, *w_in, *sb_w, *hg_lb, *hg_w, *w_out, *ffn_w, *wgr, *bgr, *wer, *ber, *weg, *weu, *wed, *ple_w, *wpp, *wpg, *fin_w;
    float* out;
    unsigned* ctl;
    float *lb, *rstd1, *rstd2, *gate, *logf;
    int *toke, *tokr, *list;
    bf16 *pb, *xn, *mix, *h2b, *sbq, *sbk, *sbv, *hq, *hk, *hv, *hgate, *h1b, *act, *y;
};

__device__ void ph_prep(const P& p, int bid, int nb) {
    const int tid = threadIdx.x, wave = tid >> 6, lane = tid & 63;
    const int gw = bid * 8 + wave, ngw = nb * 8;
    for (int m = gw; m < M; m += ngw) {
        const float4* xr = (const float4*)(p.x + (size_t)m * DM);
        float4 v[4]; float ss = 0.f;
#pragma unroll
        for (int j = 0; j < 4; ++j) { v[j] = xr[lane + 64 * j]; ss += v[j].x * v[j].x + v[j].y * v[j].y + v[j].z * v[j].z + v[j].w * v[j].w; }
        ss = wave_sum(ss);
        const float r = rsqrtf(ss * (1.0f / DM) + EPS);
        uint2* o = (uint2*)(p.xn + (size_t)m * DM);
#pragma unroll
        for (int j = 0; j < 4; ++j) {
            const float4 w = ((const float4*)p.attn_w)[lane + 64 * j];
            uint2 t; t.x = pk2(v[j].x * r * w.x, v[j].y * r * w.y); t.y = pk2(v[j].z * r * w.z, v[j].w * r * w.w);
            o[lane + 64 * j] = t;
        }
    }
    const size_t n4 = (size_t)M * PLE / 4;
    for (size_t i = (size_t)bid * NT + tid; i < n4; i += (size_t)nb * NT) {
        const float4 v = ((const float4*)p.p)[i];
        uint2 t; t.x = pk2(v.x, v.y); t.y = pk2(v.z, v.w);
        ((uint2*)p.pb)[i] = t;
    }
    if (bid == 0) {
        for (int c = tid; c < HGW; c += NT) {
            const float a = p.hg_lb[c], b = p.hg_lb[HGW + c], mx = fmaxf(a, b);
            const float ea = expf(a - mx), eb = expf(b - mx);
            p.lb[c] = ea / (ea + eb);
        }
        if (tid < NE) p.ctl[CW_CNT + tid] = 0u;
    }
}

template <int NB>
__device__ __forceinline__ void sgemm_accum(float (&acc)[NB][4][4], float* lds, const bf16* arow, const float* B0, const float* B1, int ldb, const float* kscale, int K, int col0) {
    float* As = lds;
    float* Bs = lds + 16 * 132;
    const int tid = threadIdx.x, ty = tid >> 4, tx = tid & 15;
    const int ar = tid >> 2, ak = (tid & 3) * 4;
    const int bk = tid >> 5, bn = (tid & 31) * 2;
    for (int k0 = 0; k0 < K; k0 += 16) {
        const uint2 av = *(const uint2*)(arow + k0 + ak);
        As[(ak + 0) * 132 + ar] = bflo(av.x); As[(ak + 1) * 132 + ar] = bfhi(av.x);
        As[(ak + 2) * 132 + ar] = bflo(av.y); As[(ak + 3) * 132 + ar] = bfhi(av.y);
        const float s = kscale ? kscale[k0 + bk] : 1.0f;
        {
            const float2 bv = *(const float2*)(B0 + (size_t)(k0 + bk) * ldb + col0 + bn);
            Bs[bk * 64 + bn] = bv.x * s; Bs[bk * 64 + bn + 1] = bv.y * s;
        }
        if (NB > 1) {
            const float2 bv = *(const float2*)(B1 + (size_t)(k0 + bk) * ldb + col0 + bn);
            Bs[16 * 64 + bk * 64 + bn] = bv.x * s; Bs[16 * 64 + bk * 64 + bn + 1] = bv.y * s;
        }
        __syncthreads();
#pragma unroll
        for (int kk = 0; kk < 16; ++kk) {
            const float4 a = *(const float4*)(As + kk * 132 + ty * 4);
            const float av4[4] = {a.x, a.y, a.z, a.w};
#pragma unroll
            for (int n = 0; n < NB; ++n) {
                const float4 b = *(const float4*)(Bs + n * 16 * 64 + kk * 64 + tx * 4);
                const float bv4[4] = {b.x, b.y, b.z, b.w};
#pragma unroll
                for (int i = 0; i < 4; ++i)
#pragma unroll
                    for (int j = 0; j < 4; ++j) acc[n][i][j] += av4[i] * bv4[j];
            }
        }
        __syncthreads();
    }
}

__device__ void ph_inproj(const P& p, float* lds, int bid, int nb) {
    const int tid = threadIdx.x, ty = tid >> 4, tx = tid & 15;
    constexpr int NCT = INC / 64, NU = (M / 128) * NCT;
    for (int u = bid; u < NU; u += nb) {
        const int mt = u / NCT, ct = u % NCT, m0 = mt * 128, col0 = ct * 64;
        float acc[1][4][4] = {};
        sgemm_accum<1>(acc, lds, p.xn + (size_t)(m0 + (tid >> 2)) * DM, p.w_in, nullptr, INC, nullptr, DM, col0);
        const int seg = col0 >> 9;
#pragma unroll
        for (int i = 0; i < 4; ++i) {
            const size_t m = m0 + ty * 4 + i;
#pragma unroll
            for (int j = 0; j < 4; ++j) {
                const int c = (col0 & 511) + tx * 4 + j; const float v = acc[0][i][j]; const size_t o = m * 512 + c;
                switch (seg) {
                    case 0: p.sbq[o] = f2bf(v * 0.125f); break;
                    case 1: p.sbk[o] = f2bf(v); break;
                    case 2: p.sbv[o] = f2bf(v); break;
                    case 3: p.hq[o] = f2bf(v * sigmoidf_(v)); break;
                    case 4: { const float lb = p.lb[c]; const float f = lb + (1.0f - lb) * sigmoidf_(v); p.logf[o] = logf(f); p.hk[o] = f2bf(1.0f - f); } break;
                    case 5: p.hv[o] = f2bf(v); break;
                    default: p.hgate[o] = f2bf(v * sigmoidf_(v)); break;
                }
            }
        }
    }
}

__device__ void ph_sb_naive(const P& p, int bid, int nb) {
    const int tid = threadIdx.x, wave = tid >> 6, lane = tid & 63;
    constexpr int NW = BATCH * SBH * (SEQ / 64);
    for (int w0 = bid * 8 + wave; w0 < NW; w0 += nb * 8) {
        const int w = __builtin_amdgcn_readfirstlane(w0);
        const int bh = w & 63, tb = (63 - (w >> 6)) * 64, b = bh >> 3, h = bh & 7;
        const int t = tb + lane; const size_t m = (size_t)b * SEQ + t;
        float q[64], o[64];
        {
            const uint4* qr = (const uint4*)(p.sbq + m * 512 + h * 64);
#pragma unroll
            for (int c = 0; c < 8; ++c) { const uint4 v = qr[c]; q[8 * c] = bflo(v.x); q[8 * c + 1] = bfhi(v.x); q[8 * c + 2] = bflo(v.y); q[8 * c + 3] = bfhi(v.y); q[8 * c + 4] = bflo(v.z); q[8 * c + 5] = bfhi(v.z); q[8 * c + 6] = bflo(v.w); q[8 * c + 7] = bfhi(v.w); }
        }
#pragma unroll
        for (int d = 0; d < 64; ++d) o[d] = 0.f;
        float cum = 0.f;
        const bf16* Kb = p.sbk + (size_t)b * SEQ * 512 + h * 64; const bf16* Vb = p.sbv + (size_t)b * SEQ * 512 + h * 64;
        for (int s = tb + 62; s >= 0; --s) {
            const uint4* kr = (const uint4*)(Kb + (size_t)s * 512);
            float z = 0.f;
#pragma unroll
            for (int c = 0; c < 8; ++c) { const uint4 v = kr[c]; z += q[8 * c] * bflo(v.x) + q[8 * c + 1] * bfhi(v.x) + q[8 * c + 2] * bflo(v.y) + q[8 * c + 3] * bfhi(v.y) + q[8 * c + 4] * bflo(v.z) + q[8 * c + 5] * bfhi(v.z) + q[8 * c + 6] * bflo(v.w) + q[8 * c + 7] * bfhi(v.w); }
            const float sp = fmaxf(z, 0.f) + log1pf(expf(-fabsf(z)));
            const bool on = s < t;
            const float a = on ? expf(z - sp - cum) : 0.f;
            cum += on ? sp : 0.f;
            const uint4* vr = (const uint4*)(Vb + (size_t)s * 512);
#pragma unroll
            for (int c = 0; c < 8; ++c) { const uint4 v = vr[c]; o[8 * c] += a * bflo(v.x); o[8 * c + 1] += a * bfhi(v.x); o[8 * c + 2] += a * bflo(v.y); o[8 * c + 3] += a * bfhi(v.y); o[8 * c + 4] += a * bflo(v.z); o[8 * c + 5] += a * bfhi(v.z); o[8 * c + 6] += a * bflo(v.w); o[8 * c + 7] += a * bfhi(v.w); }
        }
        float ss = 0.f;
#pragma unroll
        for (int d = 0; d < 64; ++d) ss += o[d] * o[d];
        const float r = rsqrtf(ss * (1.0f / 64) + EPS);
        uint4* mo = (uint4*)(p.mix + m * DM + h * 64); const float4* wv = (const float4*)(p.sb_w + h * 64);
#pragma unroll
        for (int c = 0; c < 8; ++c) {
            const float4 w0v = wv[2 * c], w1v = wv[2 * c + 1]; uint4 t4;
            t4.x = pk2(o[8 * c] * r * w0v.x, o[8 * c + 1] * r * w0v.y); t4.y = pk2(o[8 * c + 2] * r * w0v.z, o[8 * c + 3] * r * w0v.w);
            t4.z = pk2(o[8 * c + 4] * r * w1v.x, o[8 * c + 5] * r * w1v.y); t4.w = pk2(o[8 * c + 6] * r * w1v.z, o[8 * c + 7] * r * w1v.w);
            mo[c] = t4;
        }
    }
}

__device__ void ph_hg_naive(const P& p, int bid, int nb) {
    const int tid = threadIdx.x, wave = tid >> 6, lane = tid & 63;
    float* hgo = p.out;
    if (wave == 0) {
        for (int w0 = bid; w0 < BATCH * HGH * 2; w0 += nb) {
            const int w = __builtin_amdgcn_readfirstlane(w0);
            const int bh = w >> 1, b = bh >> 2, h = bh & 3, v = (w & 1) * 64 + lane;
            float S[128];
#pragma unroll
            for (int k = 0; k < 128; ++k) S[k] = 0.f;
            for (int t = 0; t < SEQ; ++t) {
                const size_t base = ((size_t)b * SEQ + t) * 512 + h * 128;
                const float vv = bf2f(p.hv[base + v]);
                float o = 0.f;
#pragma unroll
                for (int k4 = 0; k4 < 32; ++k4) {
                    const float4 lf = *(const float4*)(p.logf + base + 4 * k4);
                    const uint2 kk = *(const uint2*)(p.hk + base + 4 * k4), qq = *(const uint2*)(p.hq + base + 4 * k4);
                    S[4 * k4 + 0] = S[4 * k4 + 0] * __expf(lf.x) + bflo(kk.x) * vv; o += S[4 * k4 + 0] * bflo(qq.x);
                    S[4 * k4 + 1] = S[4 * k4 + 1] * __expf(lf.y) + bfhi(kk.x) * vv; o += S[4 * k4 + 1] * bfhi(qq.x);
                    S[4 * k4 + 2] = S[4 * k4 + 2] * __expf(lf.z) + bflo(kk.y) * vv; o += S[4 * k4 + 2] * bflo(qq.y);
                    S[4 * k4 + 3] = S[4 * k4 + 3] * __expf(lf.w) + bfhi(kk.y) * vv; o += S[4 * k4 + 3] * bfhi(qq.y);
                }
                hgo[base + v] = o;
            }
        }
    }
}
__device__ void ph_hg_gate(const P& p, int bid, int nb) {
    const int tid = threadIdx.x, wave = tid >> 6, lane = tid & 63;
    const float* hgo = p.out;
    for (int i = bid * 8 + wave; i < M * HGH; i += nb * 8) {
        const int m = i >> 2, h = i & 3; const size_t base = (size_t)m * 512 + h * 128 + 2 * lane;
        const float2 o = *(const float2*)(hgo + base);
        const float ss = wave_sum(o.x * o.x + o.y * o.y);
        const float r = rsqrtf(ss * (1.0f / 128) + EPS);
        const float2 w = *(const float2*)(p.hg_w + h * 128 + 2 * lane);
        const unsigned g = *(const unsigned*)(p.hgate + base);
        *(unsigned*)(p.mix + (size_t)m * DM + 512 + h * 128 + 2 * lane) = pk2(o.x * r * w.x * bflo(g), o.y * r * w.y * bfhi(g));
    }
}

__device__ void ph_outproj(const P& p, float* lds, int bid, int nb) {
    const int tid = threadIdx.x, ty = tid >> 4, tx = tid & 15;
    constexpr int NCT = DM / 64, NU = (M / 128) * NCT;
    for (int u = bid; u < NU; u += nb) {
        const int mt = u / NCT, ct = u % NCT, m0 = mt * 128, col0 = ct * 64;
        float acc[1][4][4] = {};
        sgemm_accum<1>(acc, lds, p.mix + (size_t)(m0 + (tid >> 2)) * DM, p.w_out, nullptr, DM, nullptr, DM, col0);
#pragma unroll
        for (int i = 0; i < 4; ++i) {
            const size_t o = (size_t)(m0 + ty * 4 + i) * DM + col0 + tx * 4;
            const float4 xv = *(const float4*)(p.x + o);
            float4 h; h.x = xv.x + acc[0][i][0]; h.y = xv.y + acc[0][i][1]; h.z = xv.z + acc[0][i][2]; h.w = xv.w + acc[0][i][3];
            *(float4*)(p.out + o) = h;
            uint2 t; t.x = pk2(h.x, h.y); t.y = pk2(h.z, h.w);
            *(uint2*)(p.h1b + o) = t;
        }
    }
}

__device__ void ph_route(const P& p, int bid, int nb) {
    const int tid = threadIdx.x, wave = tid >> 6, lane = tid & 63;
    for (int m = bid * 8 + wave; m < M; m += nb * 8) {
        const float4* hr = (const float4*)(p.out + (size_t)m * DM);
        float4 v[4]; float ss = 0.f;
#pragma unroll
        for (int j = 0; j < 4; ++j) { v[j] = hr[lane + 64 * j]; ss += v[j].x * v[j].x + v[j].y * v[j].y + v[j].z * v[j].z + v[j].w * v[j].w; }
        ss = wave_sum(ss);
        const float r = rsqrtf(ss * (1.0f / DM) + EPS);
        float lg[36];
#pragma unroll
        for (int e = 0; e < 36; ++e) lg[e] = 0.f;
#pragma unroll
        for (int j = 0; j < 4; ++j) {
            const float4 w = ((const float4*)p.ffn_w)[lane + 64 * j];
            const float a[4] = {v[j].x * r * w.x, v[j].y * r * w.y, v[j].z * r * w.z, v[j].w * r * w.w};
#pragma unroll
            for (int q = 0; q < 4; ++q) {
                const int k = (lane + 64 * j) * 4 + q;
                const float4 g = *(const float4*)(p.wgr + (size_t)k * 4);
                lg[0] += a[q] * g.x; lg[1] += a[q] * g.y; lg[2] += a[q] * g.z; lg[3] += a[q] * g.w;
#pragma unroll
                for (int e4 = 0; e4 < 8; ++e4) {
                    const float4 ew = *(const float4*)(p.wer + (size_t)k * 32 + e4 * 4);
                    lg[4 + e4 * 4] += a[q] * ew.x; lg[5 + e4 * 4] += a[q] * ew.y; lg[6 + e4 * 4] += a[q] * ew.z; lg[7 + e4 * 4] += a[q] * ew.w;
                }
            }
        }
#pragma unroll
        for (int e = 0; e < 36; ++e) lg[e] = wave_sum(lg[e]);
        float gl[4];
#pragma unroll
        for (int g = 0; g < 4; ++g) gl[g] = lg[g] + p.bgr[g];
        int gi = 0; float best = gl[0];
#pragma unroll
        for (int g = 1; g < 4; ++g) if (gl[g] > best) { best = gl[g]; gi = g; }
        float den = 0.f;
#pragma unroll
        for (int g = 0; g < 4; ++g) den += expf(gl[g] - best);
        const float gprob = 1.0f / den;
        float ig[8];
#pragma unroll
        for (int e = 0; e < 8; ++e) {
            const float c0 = lg[4 + e] + p.ber[e], c1 = lg[12 + e] + p.ber[8 + e], c2 = lg[20 + e] + p.ber[16 + e], c3 = lg[28 + e] + p.ber[24 + e];
            ig[e] = gi == 0 ? c0 : gi == 1 ? c1 : gi == 2 ? c2 : c3;
        }
        int i1 = 0; float v1 = ig[0];
#pragma unroll
        for (int e = 1; e < 8; ++e) if (ig[e] > v1) { v1 = ig[e]; i1 = e; }
        int i2 = -1; float v2 = -INFINITY;
#pragma unroll
        for (int e = 0; e < 8; ++e) if (e != i1 && ig[e] > v2) { v2 = ig[e]; i2 = e; }
        const float e2 = expf(v2 - v1), g1 = gprob / (1.0f + e2), g2 = gprob * e2 / (1.0f + e2);
        if (lane == 0) {
            const int ex1 = gi * 8 + i1, ex2 = gi * 8 + i2;
            const int r1 = (int)atomicAdd(&p.ctl[CW_CNT + ex1], 1u), r2 = (int)atomicAdd(&p.ctl[CW_CNT + ex2], 1u);
            p.toke[2 * m] = ex1; p.toke[2 * m + 1] = ex2; p.tokr[2 * m] = r1; p.tokr[2 * m + 1] = r2;
            p.gate[2 * m] = g1; p.gate[2 * m + 1] = g2; p.rstd1[m] = r;
            p.list[ex1 * M + r1] = m; p.list[ex2 * M + r2] = m;
        }
    }
}

struct MoeTab { int cnt[NE], off[NE + 1], tpre[NE + 1]; };
__device__ __forceinline__ void moe_tab(const P& p, MoeTab* T) {
    __syncthreads();
    if (threadIdx.x == 0) {
        int o = 0, t = 0;
        for (int e = 0; e < NE; ++e) { const int c = (int)__hip_atomic_load(&p.ctl[CW_CNT + e], __ATOMIC_RELAXED, __HIP_MEMORY_SCOPE_AGENT); T->cnt[e] = c; T->off[e] = o; T->tpre[e] = t; o += c; t += (c + 127) / 128; }
        T->off[NE] = o; T->tpre[NE] = t;
    }
    __syncthreads();
}

__device__ void ph_moe_up(const P& p, float* lds, int bid, int nb) {
    MoeTab* T = (MoeTab*)(lds + 16 * 132 + 2 * 16 * 64);
    moe_tab(p, T);
    const int tid = threadIdx.x, ty = tid >> 4, tx = tid & 15;
    constexpr int NCT = DE / 64;
    const int NU = T->tpre[NE] * NCT;
    for (int u = bid; u < NU; u += nb) {
        const int mt = u / NCT, ct = u % NCT, col0 = ct * 64;
        int e = 0; while (T->tpre[e + 1] <= mt) ++e;
        const int r0 = (mt - T->tpre[e]) * 128, cnt = T->cnt[e], off = T->off[e];
        int ar = r0 + (tid >> 2); if (ar >= cnt) ar = cnt - 1;
        const int atok = p.list[e * M + ar];
        float acc[2][4][4] = {};
        sgemm_accum<2>(acc, lds, p.h1b + (size_t)atok * DM, p.weg + (size_t)e * DM * DE, p.weu + (size_t)e * DM * DE, DE, p.ffn_w, DM, col0);
#pragma unroll
        for (int i = 0; i < 4; ++i) {
            const int ri = r0 + ty * 4 + i;
            if (ri < cnt) {
                const int tok = p.list[e * M + ri]; const float rs = p.rstd1[tok];
                float a[4];
#pragma unroll
                for (int j = 0; j < 4; ++j) { const float g = acc[0][i][j] * rs, uu = acc[1][i][j] * rs; a[j] = g * sigmoidf_(g) * uu; }
                uint2 t; t.x = pk2(a[0], a[1]); t.y = pk2(a[2], a[3]);
                *(uint2*)(p.act + (size_t)(off + ri) * DE + col0 + tx * 4) = t;
            }
        }
    }
}
__device__ void ph_moe_down(const P& p, float* lds, int bid, int nb) {
    MoeTab* T = (MoeTab*)(lds + 16 * 132 + 2 * 16 * 64);
    moe_tab(p, T);
    const int tid = threadIdx.x, ty = tid >> 4, tx = tid & 15;
    constexpr int NCT = DM / 64;
    const int NU = T->tpre[NE] * NCT;
    for (int u = bid; u < NU; u += nb) {
        const int mt = u / NCT, ct = u % NCT, col0 = ct * 64;
        int e = 0; while (T->tpre[e + 1] <= mt) ++e;
        const int r0 = (mt - T->tpre[e]) * 128, cnt = T->cnt[e], off = T->off[e];
        int ar = r0 + (tid >> 2); if (ar >= cnt) ar = cnt - 1;
        float acc[1][4][4] = {};
        sgemm_accum<1>(acc, lds, p.act + (size_t)(off + ar) * DE, p.wed + (size_t)e * DE * DM, nullptr, DM, nullptr, DE, col0);
#pragma unroll
        for (int i = 0; i < 4; ++i) {
            const int ri = r0 + ty * 4 + i;
            if (ri < cnt) {
                uint2 t; t.x = pk2(acc[0][i][0], acc[0][i][1]); t.y = pk2(acc[0][i][2], acc[0][i][3]);
                *(uint2*)(p.y + (size_t)(off + ri) * DM + col0 + tx * 4) = t;
            }
        }
    }
}
__device__ void ph_combine(const P& p, float* lds, int bid, int nb) {
    MoeTab* T = (MoeTab*)(lds + 16 * 132 + 2 * 16 * 64);
    moe_tab(p, T);
    const int tid = threadIdx.x, wave = tid >> 6, lane = tid & 63;
    for (int m = bid * 8 + wave; m < M; m += nb * 8) {
        const int e0 = p.toke[2 * m], e1 = p.toke[2 * m + 1];
        const size_t p0 = (size_t)(T->off[e0] + p.tokr[2 * m]), p1 = (size_t)(T->off[e1] + p.tokr[2 * m + 1]);
        const float g0 = p.gate[2 * m], g1 = p.gate[2 * m + 1];
        float4* hr = (float4*)(p.out + (size_t)m * DM);
        const uint2* y0 = (const uint2*)(p.y + p0 * DM); const uint2* y1 = (const uint2*)(p.y + p1 * DM);
        float4 v[4]; float ss = 0.f;
#pragma unroll
        for (int j = 0; j < 4; ++j) {
            v[j] = hr[lane + 64 * j]; const uint2 a = y0[lane + 64 * j], b = y1[lane + 64 * j];
            v[j].x += g0 * bflo(a.x) + g1 * bflo(b.x); v[j].y += g0 * bfhi(a.x) + g1 * bfhi(b.x);
            v[j].z += g0 * bflo(a.y) + g1 * bflo(b.y); v[j].w += g0 * bfhi(a.y) + g1 * bfhi(b.y);
            ss += v[j].x * v[j].x + v[j].y * v[j].y + v[j].z * v[j].z + v[j].w * v[j].w;
            hr[lane + 64 * j] = v[j];
            uint2 t; t.x = pk2(v[j].x, v[j].y); t.y = pk2(v[j].z, v[j].w);
            ((uint2*)(p.h2b + (size_t)m * DM))[lane + 64 * j] = t;
        }
        ss = wave_sum(ss);
        if (lane == 0) p.rstd2[m] = rsqrtf(ss * (1.0f / DM) + EPS);
    }
}
__device__ void ph_ple(const P& p, float* lds, int bid, int nb) {
    const int tid = threadIdx.x, ty = tid >> 4, tx = tid & 15;
    constexpr int NCT = DM / 64, NU = (M / 128) * NCT;
    for (int u = bid; u < NU; u += nb) {
        const int mt = u / NCT, ct = u % NCT, m0 = mt * 128, col0 = ct * 64;
        float ae[1][4][4] = {}, ag[1][4][4] = {};
        sgemm_accum<1>(ae, lds, p.pb + (size_t)(m0 + (tid >> 2)) * PLE, p.wpp, nullptr, DM, nullptr, PLE, col0);
        sgemm_accum<1>(ag, lds, p.h2b + (size_t)(m0 + (tid >> 2)) * DM, p.wpg, nullptr, DM, p.ple_w, DM, col0);
#pragma unroll
        for (int i = 0; i < 4; ++i) {
            const int m = m0 + ty * 4 + i; const float rs = p.rstd2[m];
            const size_t o = (size_t)m * DM + col0 + tx * 4;
            float4 h = *(const float4*)(p.out + o);
            h.x += sigmoidf_(ag[0][i][0] * rs) * ae[0][i][0]; h.y += sigmoidf_(ag[0][i][1] * rs) * ae[0][i][1];
            h.z += sigmoidf_(ag[0][i][2] * rs) * ae[0][i][2]; h.w += sigmoidf_(ag[0][i][3] * rs) * ae[0][i][3];
            *(float4*)(p.out + o) = h;
        }
    }
}
__device__ void ph_final(const P& p, int bid, int nb) {
    const int tid = threadIdx.x, wave = tid >> 6, lane = tid & 63;
    for (int m = bid * 8 + wave; m < M; m += nb * 8) {
        float4* hr = (float4*)(p.out + (size_t)m * DM);
        float4 v[4]; float ss = 0.f;
#pragma unroll
        for (int j = 0; j < 4; ++j) { v[j] = hr[lane + 64 * j]; ss += v[j].x * v[j].x + v[j].y * v[j].y + v[j].z * v[j].z + v[j].w * v[j].w; }
        ss = wave_sum(ss);
        const float r = rsqrtf(ss * (1.0f / DM) + EPS);
#pragma unroll
        for (int j = 0; j < 4; ++j) {
            const float4 w = ((const float4*)p.fin_w)[lane + 64 * j];
            float4 o; o.x = v[j].x * r * w.x; o.y = v[j].y * r * w.y; o.z = v[j].z * r * w.z; o.w = v[j].w * r * w.w;
            hr[lane + 64 * j] = o;
        }
    }
}

constexpr int LDS_FLOATS = 16 * 132 + 2 * 16 * 64 + 128;
#define PHASE_KERNEL(name, call) __global__ void __launch_bounds__(NT) name(P p) { __shared__ __attribute__((aligned(16))) float lds[LDS_FLOATS]; (void)lds; call; }
PHASE_KERNEL(k_prep, ph_prep(p, blockIdx.x, gridDim.x))
PHASE_KERNEL(k_inproj, ph_inproj(p, lds, blockIdx.x, gridDim.x))
PHASE_KERNEL(k_sb, ph_sb_naive(p, blockIdx.x, gridDim.x))
PHASE_KERNEL(k_hg, ph_hg_naive(p, blockIdx.x, gridDim.x))
PHASE_KERNEL(k_hggate, ph_hg_gate(p, blockIdx.x, gridDim.x))
PHASE_KERNEL(k_outproj, ph_outproj(p, lds, blockIdx.x, gridDim.x))
PHASE_KERNEL(k_route, ph_route(p, blockIdx.x, gridDim.x))
PHASE_KERNEL(k_moeup, ph_moe_up(p, lds, blockIdx.x, gridDim.x))
PHASE_KERNEL(k_moedown, ph_moe_down(p, lds, blockIdx.x, gridDim.x))
PHASE_KERNEL(k_combine, ph_combine(p, lds, blockIdx.x, gridDim.x))
PHASE_KERNEL(k_ple, ph_ple(p, lds, blockIdx.x, gridDim.x))
PHASE_KERNEL(k_final, ph_final(p, blockIdx.x, gridDim.x))

extern "C" void kernel_launch(void* const* d_in, const int* in_sizes, int n_in, void* d_out, int out_size, void* d_ws, size_t ws_size, hipStream_t stream) {
    if (n_in != 20 || out_size != M * DM || ws_size < WS_END) { fprintf(stderr, "kernel_launch: unexpected shapes (n_in %d, out %d, ws %zu)\n", n_in, out_size, ws_size); return; }
    P p{};
    const float** f = (const float**)&p;
    for (int i = 0; i < 20; ++i) f[i] = (const float*)d_in[i];
    unsigned char* ws = (unsigned char*)d_ws;
    p.out = (float*)d_out; p.ctl = (unsigned*)(ws + WS_CTL);
    p.lb = (float*)(ws + WS_LB); p.rstd1 = (float*)(ws + WS_RSTD1); p.rstd2 = (float*)(ws + WS_RSTD2); p.gate = (float*)(ws + WS_GATE); p.logf = (float*)(ws + WS_LOGF);
    p.toke = (int*)(ws + WS_TOKE); p.tokr = (int*)(ws + WS_TOKR); p.list = (int*)(ws + WS_LIST);
    p.pb = (bf16*)(ws + WS_PB); p.xn = (bf16*)(ws + WS_XN); p.mix = (bf16*)(ws + WS_MIX); p.h2b = (bf16*)(ws + WS_H2B);
    p.sbq = (bf16*)(ws + WS_SBQ); p.sbk = (bf16*)(ws + WS_SBK); p.sbv = (bf16*)(ws + WS_SBV);
    p.hq = (bf16*)(ws + WS_HQ); p.hk = (bf16*)(ws + WS_HK); p.hv = (bf16*)(ws + WS_HV); p.hgate = (bf16*)(ws + WS_HGATE);
    p.h1b = (bf16*)(ws + WS_H1B); p.act = (bf16*)(ws + WS_ACT); p.y = (bf16*)(ws + WS_Y);
    const int G = 1024;
    k_prep<<<G, NT, 0, stream>>>(p);
    k_inproj<<<G, NT, 0, stream>>>(p);
    k_sb<<<G, NT, 0, stream>>>(p);
    k_hg<<<64, NT, 0, stream>>>(p);
    k_hggate<<<G, NT, 0, stream>>>(p);
    k_outproj<<<G, NT, 0, stream>>>(p);
    k_route<<<G, NT, 0, stream>>>(p);
    k_moeup<<<G, NT, 0, stream>>>(p);
    k_moedown<<<G, NT, 0, stream>>>(p);
    k_combine<<<G, NT, 0, stream>>>(p);
    k_ple<<<G, NT, 0, stream>>>(p);
    k_final<<<G, NT, 0, stream>>>(p);
}
```

```cpp
#include <hip/hip_runtime.h>
#include <cstdio>
#include <cstdint>


constexpr int BATCH = 8, SEQ = 4096, DM = 1024, M = BATCH * SEQ;
constexpr int SBW = 512, SBH = 8, SBD = 64;
constexpr int HGW = 512, HGH = 4, HGD = 128;
constexpr int PLE = 256, NG = 4, EPG = 8, NE = 32, DE = 512, INC = 3584;
constexpr float EPS = 1e-6f;
constexpr int NT = 512;

typedef unsigned short bf16;
__device__ __forceinline__ bf16 f2bf(float f) { unsigned u = __float_as_uint(f); return (bf16)((u + 0x7fffu + ((u >> 16) & 1u)) >> 16); }
__device__ __forceinline__ float bf2f(bf16 h) { return __uint_as_float(((unsigned)h) << 16); }
__device__ __forceinline__ float bflo(unsigned w) { return __uint_as_float(w << 16); }
__device__ __forceinline__ float bfhi(unsigned w) { return __uint_as_float(w & 0xffff0000u); }
typedef float f32x2_t __attribute__((ext_vector_type(2))); typedef __bf16 bf16x2_t __attribute__((ext_vector_type(2)));
__device__ __forceinline__ unsigned pk2(float lo, float hi) { const f32x2_t v = {lo, hi}; const bf16x2_t b = __builtin_convertvector(v, bf16x2_t); return __builtin_bit_cast(unsigned, b); }
__device__ __forceinline__ int phase_tid() { int t = threadIdx.x; asm volatile("" : "+v"(t)); return t; }
constexpr float FP8_SH = 16.f, FP8_SW1 = 512.f, FP8_SA = 16.f, FP8_SW2 = 256.f, FP8_SY = 32.f;
__device__ __forceinline__ unsigned pk4_fp8(float a, float b, float c, float d) {
    a = __builtin_amdgcn_fmed3f(a, -448.f, 448.f); b = __builtin_amdgcn_fmed3f(b, -448.f, 448.f); c = __builtin_amdgcn_fmed3f(c, -448.f, 448.f); d = __builtin_amdgcn_fmed3f(d, -448.f, 448.f);
    unsigned w = 0; w = __builtin_amdgcn_cvt_pk_fp8_f32(a, b, w, false); w = __builtin_amdgcn_cvt_pk_fp8_f32(c, d, w, true); return w;
}
__device__ __forceinline__ float wave_sum(float v) {
#pragma unroll
    for (int o = 1; o < 64; o <<= 1) v += __shfl_xor(v, o);
    return v;
}
__device__ __forceinline__ float sigmoidf_(float x) { return 1.0f / (1.0f + expf(-x)); }

constexpr size_t MiB = 1u << 20;
constexpr size_t WS_CTL = 0;
constexpr size_t WS_LB = 1 * MiB;
constexpr size_t WS_RSTD1 = 1 * MiB + 64 * 1024;
constexpr size_t WS_RSTD2 = 1 * MiB + 256 * 1024;
constexpr size_t WS_TOKE = 2 * MiB;
constexpr size_t WS_TOKR = 2 * MiB + 512 * 1024;
constexpr size_t WS_GATE = 3 * MiB;
constexpr size_t WS_LIST = 4 * MiB;
constexpr size_t WS_WBF = 8 * MiB;
constexpr size_t WS_PB = 116 * MiB;
constexpr size_t WS_XN = 132 * MiB;
constexpr size_t WS_MIX = 132 * MiB;
constexpr size_t WS_H2B = 132 * MiB;
constexpr size_t WS_SBQ = 196 * MiB, WS_SBK = 228 * MiB;
constexpr size_t WS_VT = 260 * MiB;
constexpr size_t WS_HQ = 324 * MiB, WS_HK = 356 * MiB, WS_HGATE = 388 * MiB;
constexpr size_t WS_LOGF = 420 * MiB;
constexpr size_t WS_HGD = 484 * MiB;
constexpr size_t WS_SPREV = 196 * MiB;
constexpr size_t WS_H1B = 196 * MiB;
constexpr size_t WS_EST = 196 * MiB;
constexpr size_t WS_XS = 260 * MiB;
constexpr size_t WS_Y = 260 * MiB;
constexpr size_t WS_ACT = 390 * MiB;
constexpr size_t WS_H1Q = 324 * MiB;
constexpr size_t WS_H3B = 260 * MiB;
constexpr size_t WS_RSS = 3 * MiB + 512 * 1024;
constexpr size_t WS_END = 486 * MiB;
constexpr size_t WS_WIN = 8 * MiB, WS_WOUT = 15 * MiB, WS_WPG = 17 * MiB, WS_WPP = 19 * MiB, WS_WRT = 19 * MiB + 512 * 1024, WS_WGU = 20 * MiB, WS_WD = 84 * MiB;
constexpr int CW_CNT = 64, CNT_STRIDE = 64;

struct P {
    const float *x, *p, *attn_w, *w_in, *sb_w, *hg_lb, *hg_w, *w_out, *ffn_w, *wgr, *bgr, *wer, *ber, *weg, *weu, *wed, *ple_w, *wpp, *wpg, *fin_w;
    float* out;
    unsigned char* ws;
    __device__ __forceinline__ unsigned* ctl() const { return (unsigned*)(ws + WS_CTL); }
    __device__ __forceinline__ float* lb() const { return (float*)(ws + WS_LB); }
    __device__ __forceinline__ float* rstd1() const { return (float*)(ws + WS_RSTD1); }
    __device__ __forceinline__ float* rstd2() const { return (float*)(ws + WS_RSTD2); }
    __device__ __forceinline__ float* gate() const { return (float*)(ws + WS_GATE); }
    __device__ __forceinline__ _Float16* logf() const { return (_Float16*)(ws + WS_LOGF); }
    __device__ __forceinline__ int* toke() const { return (int*)(ws + WS_TOKE); }
    __device__ __forceinline__ int* tokr() const { return (int*)(ws + WS_TOKR); }
    __device__ __forceinline__ int* list() const { return (int*)(ws + WS_LIST); }
    __device__ __forceinline__ bf16* pb() const { return (bf16*)(ws + WS_PB); }
    __device__ __forceinline__ bf16* xn() const { return (bf16*)(ws + WS_XN); }
    __device__ __forceinline__ bf16* mix() const { return (bf16*)(ws + WS_MIX); }
    __device__ __forceinline__ bf16* h2b() const { return (bf16*)(ws + WS_H2B); }
    __device__ __forceinline__ bf16* sbq() const { return (bf16*)(ws + WS_SBQ); }
    __device__ __forceinline__ bf16* sbk() const { return (bf16*)(ws + WS_SBK); }
    __device__ __forceinline__ bf16* vt() const { return (bf16*)(ws + WS_VT); }
    __device__ __forceinline__ bf16* sprev() const { return (bf16*)(ws + WS_SPREV); }
    __device__ __forceinline__ float* hgd() const { return (float*)(ws + WS_HGD); }
    __device__ __forceinline__ bf16* hq() const { return (bf16*)(ws + WS_HQ); }
    __device__ __forceinline__ bf16* hk() const { return (bf16*)(ws + WS_HK); }
    __device__ __forceinline__ bf16* hgate() const { return (bf16*)(ws + WS_HGATE); }
    __device__ __forceinline__ bf16* h1b() const { return (bf16*)(ws + WS_H1B); }
    __device__ __forceinline__ bf16* act() const { return (bf16*)(ws + WS_ACT); }
    __device__ __forceinline__ bf16* y() const { return (bf16*)(ws + WS_Y); }
    __device__ __forceinline__ bf16* est() const { return (bf16*)(ws + WS_EST); }
    __device__ __forceinline__ bf16* win() const { return (bf16*)(ws + WS_WIN); }
    __device__ __forceinline__ bf16* wout() const { return (bf16*)(ws + WS_WOUT); }
    __device__ __forceinline__ bf16* wpg_t() const { return (bf16*)(ws + WS_WPG); }
    __device__ __forceinline__ bf16* wpp_t() const { return (bf16*)(ws + WS_WPP); }
    __device__ __forceinline__ bf16* h3b() const { return (bf16*)(ws + WS_H3B); }
    __device__ __forceinline__ unsigned char* h1q() const { return ws + WS_H1Q; }
    __device__ __forceinline__ unsigned char* wgu8() const { return ws + WS_WGU; }
    __device__ __forceinline__ unsigned char* wd8() const { return ws + WS_WD; }
    __device__ __forceinline__ unsigned char* act8() const { return ws + WS_ACT; }
    __device__ __forceinline__ unsigned char* y8() const { return ws + WS_Y; }
    __device__ __forceinline__ bf16* wrt() const { return (bf16*)(ws + WS_WRT); }
};

constexpr int LDS_BYTES = 147456, MISC_OFF = 131072 + 320, TAB_OFF = 131072 + 1024, GTAB_OFF = 131072 + 2048, GTAB_UNITS = 6, UDESC_OFF = 131072 + 2048 + 12288;

__device__ __forceinline__ void ph_prep_rows(const P& p, int bid, int nb) {
    const int tid = phase_tid(), wave = tid >> 6, lane = tid & 63;
    const int gw = bid * 8 + wave, ngw = nb * 8;
    for (int m = gw; m < M; m += ngw) {
        const float4* xr = (const float4*)(p.x + (size_t)m * DM);
        float4 v[4]; float ss = 0.f;
#pragma unroll
        for (int j = 0; j < 4; ++j) { { typedef float f4_t __attribute__((ext_vector_type(4))); const f4_t t4 = __builtin_nontemporal_load((const f4_t*)xr + lane + 64 * j); v[j] = make_float4(t4[0], t4[1], t4[2], t4[3]); } ss += v[j].x * v[j].x + v[j].y * v[j].y + v[j].z * v[j].z + v[j].w * v[j].w; }
        ss = wave_sum(ss);
        const float r = rsqrtf(ss * (1.0f / DM) + EPS);
        uint2* o = (uint2*)(p.xn() + (size_t)m * DM);
#pragma unroll
        for (int j = 0; j < 4; ++j) {
            const float4 w = ((const float4*)p.attn_w)[lane + 64 * j];
            uint2 t; t.x = pk2(v[j].x * r * w.x, v[j].y * r * w.y); t.y = pk2(v[j].z * r * w.z, v[j].w * r * w.w);
            o[lane + 64 * j] = t;
        }
    }
    const size_t n4 = (size_t)M * PLE / 4;
    for (size_t i = (size_t)bid * NT + tid; i < n4; i += (size_t)nb * NT) {
        typedef float f4_t __attribute__((ext_vector_type(4))); const f4_t t4 = __builtin_nontemporal_load((const f4_t*)p.p + i); const float4 v = make_float4(t4[0], t4[1], t4[2], t4[3]);
        uint2 t; t.x = pk2(v.x, v.y); t.y = pk2(v.z, v.w);
        ((uint2*)p.pb())[i] = t;
    }
    if (bid == 0) {
        for (int c = tid; c < HGW; c += NT) {
            const float a = p.hg_lb[c], b = p.hg_lb[HGW + c], mx = fmaxf(a, b);
            const float ea = expf(a - mx), eb = expf(b - mx);
            p.lb()[c] = ea / (ea + eb);
        }
    }
}

#define LAS __attribute__((address_space(3)))
#define XB_TMO      128
#define XB_XCNT(j)  (256  + 64 * (j))
#define XB_XSUB(j)  (1280 + 64 * (j))
#define XB_XGEN(j)  (2304 + 64 * (j))
#define XB_TOP      3328
#define XB_TOPGEN   3392
#define XCD_BAR_WORDS 3456
#define XB_SPIN_CAP (1u << 18)
__device__ __forceinline__ unsigned xb_ld(unsigned* p)              { return __hip_atomic_load(p, __ATOMIC_RELAXED, __HIP_MEMORY_SCOPE_AGENT); }
__device__ __forceinline__ unsigned xb_add(unsigned* p, unsigned v) { return __hip_atomic_fetch_add(p, v, __ATOMIC_RELAXED, __HIP_MEMORY_SCOPE_AGENT); }
__device__ __forceinline__ unsigned xb_xcc_id() { return (unsigned)__builtin_amdgcn_s_getreg((3 << 11) | 20) & 0xFu; }
#define XB_SPIN(cond, bar) do { unsigned _sp = 0; while (cond) { __builtin_amdgcn_s_sleep(1); \
    if ((++_sp & 255u) == 0u) { if (xb_ld(&(bar)[XB_TMO])) break; if (_sp > XB_SPIN_CAP) { atomicAdd(&(bar)[XB_TMO], 1u); break; } } } } while (0)
struct XcdBarrier { unsigned* bar; unsigned x; volatile LAS unsigned* st; };
__device__ __forceinline__ XcdBarrier xcd_barrier_post(unsigned* bar, volatile LAS unsigned* st) {
    XcdBarrier b; b.bar = bar; b.x = xb_xcc_id(); b.st = st;
    if (threadIdx.x == 0) (void)xb_add(&bar[XB_XCNT(b.x)], 1u);
    return b;
}
__device__ __forceinline__ void xcd_barrier_complete(unsigned* bar, unsigned x, unsigned& nloc, unsigned& nx) {
    const unsigned G = gridDim.x * gridDim.y * gridDim.z;
    unsigned sum, cnt, mine, sp = 0u;
    for (;;) {
        sum = 0u; cnt = 0u; mine = 0u;
#pragma unroll
        for (unsigned j = 0; j < 16; ++j) { const unsigned c = xb_ld(&bar[XB_XCNT(j)]); sum += c; cnt += (c > 0u) ? 1u : 0u; mine = (j == x) ? c : mine; }
        if (sum == G) break;
        __builtin_amdgcn_s_sleep(1);
        if ((++sp & 255u) == 0u) { if (xb_ld(&bar[XB_TMO])) break; if (sp > XB_SPIN_CAP) { atomicAdd(&bar[XB_TMO], 1u); break; } }
    }
    nloc = mine > 0u ? mine : 1u; nx = cnt > 0u ? cnt : 1u;
}
__device__ __forceinline__ void xcd_barrier(const XcdBarrier& b) {
    asm volatile("s_waitcnt vmcnt(0)" ::: "memory");
    __syncthreads();
    if (threadIdx.x == 0) {
        unsigned* bar = b.bar;
        __builtin_amdgcn_s_waitcnt(0);
        unsigned nloc = b.st[0], nx = b.st[1];
        if (nloc == 0u) { xcd_barrier_complete(bar, b.x, nloc, nx); b.st[0] = nloc; b.st[1] = nx; }
        const unsigned old = xb_add(&bar[XB_XSUB(b.x)], 1u);
        const unsigned gen = old / nloc;
        if (old + 1u == (gen + 1u) * nloc) {
            __builtin_amdgcn_fence(__ATOMIC_RELEASE, "agent");
            asm volatile("s_waitcnt vmcnt(0)" ::: "memory");
            const unsigned og = xb_add(&bar[XB_TOP], 1u);
            const unsigned tg = og / nx;
            if (og + 1u == (tg + 1u) * nx) xb_add(&bar[XB_TOPGEN], 1u);
            else XB_SPIN(xb_ld(&bar[XB_TOPGEN]) == tg, bar);
            __builtin_amdgcn_fence(__ATOMIC_ACQUIRE, "agent");
            xb_add(&bar[XB_XGEN(b.x)], 1u);
            asm volatile("s_waitcnt vmcnt(0)" ::: "memory");
        } else {
            XB_SPIN(xb_ld(&bar[XB_XGEN(b.x)]) == gen, bar);
            __builtin_amdgcn_fence(__ATOMIC_ACQUIRE, "agent");
            asm volatile("s_waitcnt vmcnt(0)" ::: "memory");
        }
    }
    __syncthreads();
}


namespace pg8 {
#define PG8_LAS __attribute__((address_space(3)))
typedef short bf16x8 __attribute__((ext_vector_type(8)));
typedef float f32x4 __attribute__((ext_vector_type(4)));
typedef unsigned u32x4 __attribute__((ext_vector_type(4)));
typedef int i32x8 __attribute__((ext_vector_type(8)));
typedef int i32x4 __attribute__((ext_vector_type(4)));
constexpr int BM = 256, BK = 64, HALF = 128, HTB = HALF * BK * 2  , STAGE_BYTES = 8 * HTB, NXCD = 8, WGM = 8;
__host__ __device__ __forceinline__ int lds_byte(int r, int c) { const int st = (r >> 4) * 2 + (c >> 5), rr = r & 15, cc = c & 31, ob = rr * 64 + cc * 2; return st * 1024 + (ob ^ (((ob >> 9) & 1) << 5)); }
__host__ __device__ __forceinline__ void stage_rc(int b, int& R, int& C) { const int st = b / 1024, sb = b % 1024, swz = sb ^ (((sb >> 9) & 1) << 5); R = (st >> 1) * 16 + swz / 64; C = (st & 1) * 32 + (swz % 64) / 2; }
__host__ __device__ __forceinline__ int perm32(int rho) { const int n = rho >> 4, i = rho & 15; return 8 * (i >> 2) + 4 * n + (i & 3); }

struct Unit { const char* A; const char* B; int row0, pn, valid, aux; };

template <bool GATHER = false, bool FP8 = false, class Epi, class Sched>
__device__ __forceinline__ void gemm_phase(PG8_LAS unsigned char* lds, const int K, const Sched& S, const Epi& E, const char* A0 = nullptr, const PG8_LAS int* gtab = nullptr) {
    const int tid = phase_tid(), wid = __builtin_amdgcn_readfirstlane(tid >> 6), lane = tid & 63, wr = wid >> 2, wc = wid & 3, fr = lane & 15, fq = lane >> 4;
    const int nt = K / BK;
    unsigned voffA[2], voffB[2];
#pragma unroll
    for (int i = 0; i < 2; ++i) { int R, C; stage_rc(tid * 16 + i * 8192, R, C); const int Rb = (R & ~31) + perm32(R & 31);
        voffA[i] = (unsigned)(R * K + C) * 2u; voffB[i] = (unsigned)(Rb * K + C) * 2u; }
    const size_t kstep = (size_t)(BK * 2);
    const size_t hstep = (size_t)HALF * K * 2;
    const unsigned ldsw = (unsigned)wid * 1024u;
    const int fcol = fq * 8;
    const int aoff = lds_byte(wr * 64 + fr, fcol), boff = lds_byte(wc * 32 + fr, fcol);
#define PG8_SA(b, h) (((b) * 2 + (h)) * HTB)
#define PG8_SB(b, h) ((4 + (b) * 2 + (h)) * HTB)
#define PG8_STAGE(bufoff, gbase, voff) do { _Pragma("unroll") for (int _i = 0; _i < 2; ++_i) \
        __builtin_amdgcn_global_load_lds((const unsigned*)((const char*)(gbase) + (voff)[_i]), (PG8_LAS unsigned*)(lds + (bufoff) + ldsw + _i * 8192), 16, 0, 0); } while (0)
#define PG8_LDA(dst, b, h) do { if constexpr (FP8) { _Pragma("unroll") for (int m = 0; m < 4; ++m) dst##8[m] = __builtin_shufflevector(*(const PG8_LAS i32x4*)(lds + PG8_SA(b, h) + aoff + m * 2048), *(const PG8_LAS i32x4*)(lds + PG8_SA(b, h) + aoff + m * 2048 + 1024), 0, 1, 2, 3, 4, 5, 6, 7); } \
        else { _Pragma("unroll") for (int m = 0; m < 4; ++m) _Pragma("unroll") for (int k = 0; k < 2; ++k) dst[m][k] = *(const PG8_LAS bf16x8*)(lds + PG8_SA(b, h) + aoff + m * 2048 + k * 1024); } } while (0)
#define PG8_LDB(dst, b, h) do { if constexpr (FP8) { _Pragma("unroll") for (int n = 0; n < 2; ++n) dst##8[n] = __builtin_shufflevector(*(const PG8_LAS i32x4*)(lds + PG8_SB(b, h) + boff + n * 2048), *(const PG8_LAS i32x4*)(lds + PG8_SB(b, h) + boff + n * 2048 + 1024), 0, 1, 2, 3, 4, 5, 6, 7); } \
        else { _Pragma("unroll") for (int n = 0; n < 2; ++n) _Pragma("unroll") for (int k = 0; k < 2; ++k) dst[n][k] = *(const PG8_LAS bf16x8*)(lds + PG8_SB(b, h) + boff + n * 2048 + k * 1024); } } while (0)
#define PG8_MMA(ai, bj, At, Bt) do { __builtin_amdgcn_s_setprio(1); _Pragma("unroll") for (int m = 0; m < 4; ++m) _Pragma("unroll") for (int n = 0; n < 2; ++n) { \
        if constexpr (FP8) asm volatile("v_mfma_f32_16x16x128_f8f6f4 %0, %1, %2, %0" : "+v"(acc[ai][bj][m][n]) : "v"(Bt##8[n]), "v"(At##8[m]));   \
        else { _Pragma("unroll") for (int k = 0; k < 2; ++k) acc[ai][bj][m][n] = __builtin_amdgcn_mfma_f32_16x16x32_bf16(Bt[n][k], At[m][k], acc[ai][bj][m][n], 0, 0, 0); } } \
        __builtin_amdgcn_s_setprio(0); } while (0)
#define PG8_WAIT_V(n) asm volatile("s_waitcnt vmcnt(" #n ")" ::: "memory")
#define PG8_WAIT_L(n) asm volatile("s_waitcnt lgkmcnt(" #n ")" ::: "memory")
#define PG8_BAR __builtin_amdgcn_s_barrier()
#define PG8_SCHED __builtin_amdgcn_sched_barrier(0)
    Unit cur, nxt; int ui = 0;
    if (!S.next(0, cur)) return;
    unsigned goff[2][2] = {{0u, 0u}, {0u, 0u}};
#define PG8_GLOAD(un) do { const PG8_LAS int* t_ = gtab + (un) * 256; \
        _Pragma("unroll") for (int i_ = 0; i_ < 2; ++i_) { int R_, C_; stage_rc(tid * 16 + i_ * 8192, R_, C_); \
            goff[0][i_] = (unsigned)t_[R_] * (unsigned)(2 * K) + (unsigned)(2 * C_); goff[1][i_] = (unsigned)t_[128 + R_] * (unsigned)(2 * K) + (unsigned)(2 * C_); } } while (0)
    if constexpr (GATHER) PG8_GLOAD(0);
#define PG8_STAGE_A(bufoff, kp, h) do { if constexpr (GATHER) PG8_STAGE(bufoff, kp, goff[h]); else PG8_STAGE(bufoff, (kp) + (h) * hstep, voffA); } while (0)
    f32x4 acc[2][2][4][2];
#pragma unroll
    for (int a = 0; a < 2; ++a)
#pragma unroll
        for (int b = 0; b < 2; ++b)
#pragma unroll
            for (int m = 0; m < 4; ++m)
#pragma unroll
                for (int n = 0; n < 2; ++n) acc[a][b][m][n] = (f32x4){0.f, 0.f, 0.f, 0.f};
    bf16x8 At[4][2], B0[2][2], B1[2][2];
    i32x8 At8[4], B08[2], B18[2];
    const char* cA = GATHER ? A0 : cur.A; const char* cB = cur.B;
    PG8_STAGE(PG8_SB(0, 0), cB, voffB); PG8_STAGE(PG8_SB(0, 1), cB + hstep, voffB); PG8_STAGE_A(PG8_SA(0, 0), cA, 0); PG8_STAGE_A(PG8_SA(0, 1), cA, 1);
    if (wr == 1) PG8_BAR;
    PG8_WAIT_V(2); PG8_BAR;
    PG8_STAGE(PG8_SB(1, 0), cB + kstep, voffB); PG8_STAGE_A(PG8_SA(1, 0), cA + kstep, 0); PG8_STAGE(PG8_SB(1, 1), cB + hstep + kstep, voffB);
    PG8_WAIT_V(6); PG8_BAR;
    for (;;) {
        const bool has_next = S.next(ui + 1, nxt);
        const char* nA = GATHER ? A0 : (has_next ? nxt.A : cA); const char* nB = has_next ? nxt.B : cB;
#pragma unroll 1
        for (int t = 0; t < nt; t += 2) {
            const bool last = (t == nt - 2);
            const char* a1 = cA + (size_t)(t + 1) * kstep;
            const char* a2 = last ? nA : cA + (size_t)(t + 2) * kstep; const char* b2 = last ? nB : cB + (size_t)(t + 2) * kstep;
            const char* a3 = a2 + kstep; const char* b3 = b2 + kstep;
            PG8_LDB(B0, 0, 0); PG8_LDB(B1, 0, 1); PG8_SCHED; PG8_LDA(At, 0, 0); PG8_STAGE_A(PG8_SA(1, 1), a1, 1);
            if constexpr (GATHER) { if (last && has_next) PG8_GLOAD(ui + 1); }
            PG8_WAIT_V(8); PG8_WAIT_L(0); PG8_BAR; PG8_MMA(0, 0, At, B0); PG8_MMA(0, 1, At, B1); PG8_BAR; PG8_SCHED;
            PG8_LDA(At, 0, 1); PG8_STAGE(PG8_SB(0, 0), b2, voffB); PG8_STAGE(PG8_SB(0, 1), b2 + hstep, voffB); PG8_STAGE_A(PG8_SA(0, 0), a2, 0);
            PG8_WAIT_V(8); PG8_WAIT_L(0); PG8_BAR; PG8_MMA(1, 0, At, B0); PG8_MMA(1, 1, At, B1); PG8_BAR; PG8_SCHED;
            PG8_LDB(B0, 1, 0); PG8_LDB(B1, 1, 1); PG8_SCHED; PG8_LDA(At, 1, 0); PG8_STAGE_A(PG8_SA(0, 1), a2, 1);
            PG8_WAIT_V(8); PG8_WAIT_L(0); PG8_BAR; PG8_MMA(0, 0, At, B0); PG8_MMA(0, 1, At, B1); PG8_BAR; PG8_SCHED;
            PG8_LDA(At, 1, 1); PG8_STAGE(PG8_SB(1, 0), b3, voffB); PG8_STAGE(PG8_SB(1, 1), b3 + hstep, voffB); PG8_STAGE_A(PG8_SA(1, 0), a3, 0);
            PG8_WAIT_V(8); PG8_WAIT_L(0); PG8_BAR; PG8_MMA(1, 0, At, B0); PG8_MMA(1, 1, At, B1); PG8_BAR; PG8_SCHED;
        }
        if (wr == 0) PG8_BAR;
        if constexpr (FP8) asm volatile("s_nop 15\n\ts_nop 15" ::: "memory");
        E(acc, cur, wr, wc, fr, fq);
        if (!has_next) break;
#pragma unroll
        for (int a = 0; a < 2; ++a)
#pragma unroll
            for (int b = 0; b < 2; ++b)
#pragma unroll
                for (int m = 0; m < 4; ++m)
#pragma unroll
                    for (int n = 0; n < 2; ++n) acc[a][b][m][n] = (f32x4){0.f, 0.f, 0.f, 0.f};
        cur = nxt; cA = nA; cB = nB; ++ui;
        if (wr == 1) PG8_BAR;
    }
    PG8_WAIT_V(0);
    PG8_BAR;
#undef PG8_SA
#undef PG8_SB
#undef PG8_STAGE
#undef PG8_STAGE_A
#undef PG8_GLOAD
#undef PG8_LDA
#undef PG8_LDB
#undef PG8_MMA
#undef PG8_WAIT_V
#undef PG8_WAIT_L
#undef PG8_BAR
#undef PG8_SCHED
}

struct DenseOrder {
    const char* A; const char* B; int nM, nN, nwg, G, c; size_t tstep;
    __device__ void init(const void* A_, const void* B_, int M_, int N_, int K_, int G_, int c_) { A = (const char*)A_; B = (const char*)B_; nM = M_ / BM; nN = N_ / BM; nwg = nM * nN; G = G_; c = c_; tstep = (size_t)BM * K_ * 2; }
    __device__ bool next(int i, Unit& u) const {
        const long L = (long)i * G + c; if (L >= nwg) return false;
        int wgid = (int)L; { const int q = nwg / NXCD, r = nwg % NXCD, xcd = wgid % NXCD, off = wgid / NXCD; wgid = (xcd < r ? xcd * (q + 1) : r * (q + 1) + (xcd - r) * q) + off; }
        const int nig = WGM * nN, gid = wgid / nig, fm = gid * WGM, gsz = (nM - fm) < WGM ? (nM - fm) : WGM;
        const int pm = fm + ((wgid % nig) % gsz), pn = (wgid % nig) / gsz;
        u.A = A + (size_t)pm * tstep; u.B = B + (size_t)pn * tstep; u.row0 = pm * BM; u.pn = pn; u.valid = BM; u.aux = 0; return true;
    }
};
}

typedef float f32x4 __attribute__((ext_vector_type(4)));
typedef unsigned u32x4 __attribute__((ext_vector_type(4)));
typedef unsigned u32x2 __attribute__((ext_vector_type(2)));
typedef float f32x2 __attribute__((ext_vector_type(2)));
constexpr float QSCALE = 0.125f * 1.4426950408889634f;
__device__ __forceinline__ float fsigmoid(float x) { return __builtin_amdgcn_rcpf(1.0f + __builtin_amdgcn_exp2f(-1.4426950408889634f * x)); }

struct MoeTab { int cnt[NE], off[NE + 1], tpre[NE + 1]; };
__device__ __forceinline__ void moe_tab(const P& p, MoeTab* T) {
    __syncthreads();
    if (threadIdx.x == 0) {
        int o = 0, t = 0;
        for (int e = 0; e < NE; ++e) { const int c = (int)__hip_atomic_load(&p.ctl()[CW_CNT + e * CNT_STRIDE], __ATOMIC_RELAXED, __HIP_MEMORY_SCOPE_AGENT); T->cnt[e] = c; T->off[e] = o; T->tpre[e] = t; o += c; t += (c + 255) / 256; }
        T->off[NE] = o; T->tpre[NE] = t;
    }
    __syncthreads();
}
__device__ __forceinline__ bool moe_unit(const MoeTab* T, int i, int c, int G, int& mt, int& pn) {
    if ((G & 31) == 0) { const int per = G >> 3, mpg = per >> 2, x = c & 7, j = c >> 3; mt = (i * 8 + x) * mpg + (j >> 2); pn = j & 3; }
    else { const int L = i * G + c; mt = L >> 2; pn = L & 3; }
    return mt < T->tpre[NE];
}
struct MoeOrder {
    const LAS int* ud; const char* A; const char* B; size_t a_pitch, b_exp; size_t b_tile;
    __device__ bool next(int i, pg8::Unit& u) const {
        if (i >= GTAB_UNITS) return false;
        const int row0 = ud[4 * i], valid = ud[4 * i + 1], e = ud[4 * i + 2], pn = ud[4 * i + 3];
        if (valid == 0) return false;
        u.row0 = row0; u.valid = valid; u.pn = pn; u.aux = i;
        u.A = A + (size_t)row0 * a_pitch; u.B = B + (size_t)e * b_exp + (size_t)pn * b_tile; return true;
    }
};

#define EPI_FR int frl_ = fr; asm volatile("" : "+v"(frl_));
#define EPI_ROWS_BEGIN _Pragma("unroll") for (int ai = 0; ai < 2; ++ai) _Pragma("unroll") for (int m = 0; m < 4; ++m) { const int rt = ai * 128 + wr * 64 + m * 16 + frl_;
#define EPI_ROWS_END }
__device__ __forceinline__ u32x4 pack8(const f32x4 a, const f32x4 b) { u32x4 w; w.x = pk2(a[0], a[1]); w.y = pk2(a[2], a[3]); w.z = pk2(b[0], b[1]); w.w = pk2(b[2], b[3]); return w; }

struct EpiInProj {
    P p;
    template <int SEG>
    __device__ __forceinline__ void rows(const f32x4 (&acc)[2][2][4][2], const pg8::Unit& u, int wr, int frl_, int cb, bf16* dst) const {
#pragma unroll
        for (int bj = 0; bj < 2; ++bj) {
            const int c = cb + bj * 128;
            f32x4 l0 = {0.f, 0.f, 0.f, 0.f}, l1 = l0;
            if (SEG == 3) { l0 = *(const f32x4*)(p.lb() + c); l1 = *(const f32x4*)(p.lb() + c + 4); asm volatile("" : "+v"(l0), "+v"(l1)); }
            EPI_ROWS_BEGIN
                const size_t o = (size_t)(u.row0 + rt) * 512 + c;
                f32x4 v0 = acc[ai][bj][m][0], v1 = acc[ai][bj][m][1];
                if (SEG == 0) { v0 = v0 * QSCALE; v1 = v1 * QSCALE; }
                else if (SEG == 2 || SEG == 4) {
#pragma unroll
                    for (int q = 0; q < 4; ++q) { v0[q] = v0[q] * fsigmoid(v0[q]); v1[q] = v1[q] * fsigmoid(v1[q]); }
                } else if (SEG == 3) {
                    f32x4 g0, g1;
#pragma unroll
                    for (int q = 0; q < 4; ++q) {
                        const float f0 = l0[q] + (1.0f - l0[q]) * fsigmoid(v0[q]), f1 = l1[q] + (1.0f - l1[q]) * fsigmoid(v1[q]);
                        g0[q] = __logf(f0); g1[q] = __logf(f1); v0[q] = 1.0f - f0; v1[q] = 1.0f - f1;
                    }
                    typedef _Float16 f16x8 __attribute__((ext_vector_type(8)));
                    *(f16x8*)(p.logf() + o) = (f16x8){(_Float16)g0[0], (_Float16)g0[1], (_Float16)g0[2], (_Float16)g0[3], (_Float16)g1[0], (_Float16)g1[1], (_Float16)g1[2], (_Float16)g1[3]};
                }
                *(u32x4*)(dst + o) = pack8(v0, v1);
            EPI_ROWS_END
        }
    }
    __device__ __forceinline__ void operator()(const f32x4 (&acc)[2][2][4][2], const pg8::Unit& u, int wr, int wc, int fr, int fq) const {
        EPI_FR
        const int colt = u.pn * 256, seg = colt >> 9, cb = (colt & 511) + wc * 32 + 8 * fq;
        if (seg == 0) rows<0>(acc, u, wr, frl_, cb, p.sbq());
        else if (seg == 1) rows<1>(acc, u, wr, frl_, cb, p.sbk());
        else if (seg == 2) rows<2>(acc, u, wr, frl_, cb, p.hq());
        else if (seg == 3) rows<3>(acc, u, wr, frl_, cb, p.hk());
        else rows<4>(acc, u, wr, frl_, cb, p.hgate());
    }
};
struct EpiVT {
    P p;
    __device__ __forceinline__ void operator()(const f32x4 (&acc)[2][2][4][2], const pg8::Unit& u, int wr, int wc, int fr, int fq) const {
        EPI_FR
#pragma unroll
        for (int bj = 0; bj < 2; ++bj) {
            const int c = u.pn * 256 + bj * 128 + wc * 32 + 8 * fq;
            EPI_ROWS_BEGIN *(u32x4*)(p.vt() + (size_t)(u.row0 + rt) * M + c) = pack8(acc[ai][bj][m][0], acc[ai][bj][m][1]); EPI_ROWS_END
        }
    }
};
struct EpiOutProj {
    P p;
    __device__ __forceinline__ void operator()(const f32x4 (&acc)[2][2][4][2], const pg8::Unit& u, int wr, int wc, int fr, int fq) const {
        EPI_FR
        const int cb = u.pn * 256 + wc * 32 + 8 * fq;
        f32x4 xa[2][4], xb[2][4];
#define OP_LD(b, s) _Pragma("unroll") for (int m = 0; m < 4; ++m) { const size_t o = (size_t)(u.row0 + ((b) & 1) * 128 + wr * 64 + m * 16 + frl_) * DM + cb + ((b) >> 1) * 128; \
            xa[s][m] = *(const f32x4*)(p.x + o); xb[s][m] = *(const f32x4*)(p.x + o + 4); }
#define OP_CS(b, s) _Pragma("unroll") for (int m = 0; m < 4; ++m) { const size_t o = (size_t)(u.row0 + ((b) & 1) * 128 + wr * 64 + m * 16 + frl_) * DM + cb + ((b) >> 1) * 128; \
            const f32x4 h0 = xa[s][m] + acc[(b) & 1][(b) >> 1][m][0], h1 = xb[s][m] + acc[(b) & 1][(b) >> 1][m][1]; \
            *(u32x4*)(p.h1b() + o) = pack8(h0, h1); \
            const f32x4 q0 = h0 * FP8_SH, q1 = h1 * FP8_SH; \
            *(u32x2*)(p.h1q() + o) = (u32x2){pk4_fp8(q0[0], q0[1], q0[2], q0[3]), pk4_fp8(q1[0], q1[1], q1[2], q1[3])}; }
        OP_LD(0, 0) OP_LD(1, 1) OP_CS(0, 0) OP_LD(2, 0) OP_CS(1, 1) OP_LD(3, 1) OP_CS(2, 0) OP_CS(3, 1)
#undef OP_LD
#undef OP_CS
    }
};
struct EpiMoeUp {
    P p; const LAS float* rtab;
    __device__ __forceinline__ void operator()(const f32x4 (&acc)[2][2][4][2], const pg8::Unit& u, int wr, int wc, int fr, int fq) const {
        EPI_FR
        const int c = u.pn * 128 + wc * 32 + 8 * fq;
        EPI_ROWS_BEGIN
            if (rt < u.valid) {
                const float rs = rtab[u.aux * 256 + rt] * (1.0f / (FP8_SH * FP8_SW1));
                f32x4 a0, a1;
#pragma unroll
                for (int q = 0; q < 4; ++q) {
                    const float g0 = acc[ai][0][m][0][q] * rs, g1 = acc[ai][0][m][1][q] * rs;
                    a0[q] = g0 * fsigmoid(g0) * (acc[ai][1][m][0][q] * rs) * FP8_SA; a1[q] = g1 * fsigmoid(g1) * (acc[ai][1][m][1][q] * rs) * FP8_SA;
                }
                *(u32x2*)(p.act8() + (size_t)(u.row0 + rt) * DE + c) = (u32x2){pk4_fp8(a0[0], a0[1], a0[2], a0[3]), pk4_fp8(a1[0], a1[1], a1[2], a1[3])};
            }
        EPI_ROWS_END
    }
};
struct EpiMoeDown {
    P p;
    __device__ __forceinline__ void operator()(const f32x4 (&acc)[2][2][4][2], const pg8::Unit& u, int wr, int wc, int fr, int fq) const {
        EPI_FR
        constexpr float sc = FP8_SY / (FP8_SA * FP8_SW2);
#pragma unroll
        for (int bj = 0; bj < 2; ++bj) {
            const int c = u.pn * 256 + bj * 128 + wc * 32 + 8 * fq;
            EPI_ROWS_BEGIN
                if (rt < u.valid) { const f32x4 a = acc[ai][bj][m][0] * sc, b = acc[ai][bj][m][1] * sc;
                    *(u32x2*)(p.y8() + (size_t)(u.row0 + rt) * DM + c) = (u32x2){pk4_fp8(a[0], a[1], a[2], a[3]), pk4_fp8(b[0], b[1], b[2], b[3])}; }
            EPI_ROWS_END
        }
    }
};
struct EpiPleE {
    P p;
    __device__ __forceinline__ void operator()(const f32x4 (&acc)[2][2][4][2], const pg8::Unit& u, int wr, int wc, int fr, int fq) const {
        EPI_FR
#pragma unroll
        for (int bj = 0; bj < 2; ++bj) {
            const int c = u.pn * 256 + bj * 128 + wc * 32 + 8 * fq;
            EPI_ROWS_BEGIN *(u32x4*)(p.est() + (size_t)(u.row0 + rt) * DM + c) = pack8(acc[ai][bj][m][0], acc[ai][bj][m][1]); EPI_ROWS_END
        }
    }
};
struct EpiPleGate {
    P p;
    __device__ __forceinline__ void operator()(const f32x4 (&acc)[2][2][4][2], const pg8::Unit& u, int wr, int wc, int fr, int fq) const {
        EPI_FR
        const int cb = u.pn * 256 + wc * 32 + 8 * fq;
        u32x4 ev[2][4], hv[2][4]; float rv[2][4];
#define PG_LD(b, s) _Pragma("unroll") for (int m = 0; m < 4; ++m) { const int row = u.row0 + ((b) & 1) * 128 + wr * 64 + m * 16 + frl_; const size_t o = (size_t)row * DM + cb + ((b) >> 1) * 128; \
            rv[s][m] = p.rstd2()[row]; ev[s][m] = *(const u32x4*)(p.est() + o); hv[s][m] = *(const u32x4*)(p.h2b() + o); }
#define PG_CS(b, s) _Pragma("unroll") for (int m = 0; m < 4; ++m) { const size_t o = (size_t)(u.row0 + ((b) & 1) * 128 + wr * 64 + m * 16 + frl_) * DM + cb + ((b) >> 1) * 128; \
            const float rs = rv[s][m]; const u32x4 e = ev[s][m], hb = hv[s][m]; \
            const f32x4 g0 = acc[(b) & 1][(b) >> 1][m][0], g1 = acc[(b) & 1][(b) >> 1][m][1]; \
            f32x4 h0, h1; \
            h0[0] = bflo(hb.x) + fsigmoid(g0[0] * rs) * bflo(e.x); h0[1] = bfhi(hb.x) + fsigmoid(g0[1] * rs) * bfhi(e.x); h0[2] = bflo(hb.y) + fsigmoid(g0[2] * rs) * bflo(e.y); h0[3] = bfhi(hb.y) + fsigmoid(g0[3] * rs) * bfhi(e.y); \
            h1[0] = bflo(hb.z) + fsigmoid(g1[0] * rs) * bflo(e.z); h1[1] = bfhi(hb.z) + fsigmoid(g1[1] * rs) * bfhi(e.z); h1[2] = bflo(hb.w) + fsigmoid(g1[2] * rs) * bflo(e.w); h1[3] = bfhi(hb.w) + fsigmoid(g1[3] * rs) * bfhi(e.w); \
            *(u32x4*)(p.h3b() + o) = pack8(h0, h1); }
        PG_LD(0, 0) PG_CS(0, 0) PG_LD(1, 1) PG_LD(2, 0) PG_CS(1, 1) PG_LD(3, 1) PG_CS(2, 0) PG_CS(3, 1)
#undef PG_LD
#undef PG_CS
    }
};

struct TItem { const float* W; bf16* WT; unsigned char* WT8; const float* ks; const float* dummy; float wscale; int K, N, rowmode, k0, n0; };
__device__ __forceinline__ TItem t_decode(const P& p, int it) {
    constexpr int I_IN = 16 * (INC / 64), I_SQ = 16 * 16, I_PP = 4 * 16, I_G = 16 * 8, I_D = 8 * 16;
    TItem t; int r = it; t.WT8 = nullptr; t.wscale = 1.f; t.dummy = p.attn_w;
    if (r < I_IN) { t.W = p.w_in; t.WT = p.win(); t.ks = nullptr; t.K = DM; t.N = INC; t.rowmode = 3; }
    else if ((r -= I_IN) < I_SQ) { t.W = p.w_out; t.WT = p.wout(); t.ks = nullptr; t.K = DM; t.N = DM; t.rowmode = 0; }
    else if ((r -= I_SQ) < I_SQ) { t.W = p.wpg; t.WT = p.wpg_t(); t.ks = p.ple_w; t.K = DM; t.N = DM; t.rowmode = 0; }
    else if ((r -= I_SQ) < I_PP) { t.W = p.wpp; t.WT = p.wpp_t(); t.ks = nullptr; t.K = PLE; t.N = DM; t.rowmode = 0; }
    else {
        r -= I_PP; const int e = r / (2 * I_G + I_D); r -= e * (2 * I_G + I_D);
        if (r < I_G) { t.W = p.weg + (size_t)e * DM * DE; t.WT = nullptr; t.WT8 = p.wgu8() + (size_t)e * DM * DM; t.wscale = FP8_SW1; t.ks = p.ffn_w; t.K = DM; t.N = DE; t.rowmode = 1; }
        else if ((r -= I_G) < I_G) { t.W = p.weu + (size_t)e * DM * DE; t.WT = nullptr; t.WT8 = p.wgu8() + (size_t)e * DM * DM; t.wscale = FP8_SW1; t.ks = p.ffn_w; t.K = DM; t.N = DE; t.rowmode = 2; }
        else { r -= I_G; t.W = p.wed + (size_t)e * DE * DM; t.WT = nullptr; t.WT8 = p.wd8() + (size_t)e * DM * DE; t.wscale = FP8_SW2; t.ks = nullptr; t.K = DE; t.N = DM; t.rowmode = 0; }
    }
    const int nblk = t.N / 64; t.k0 = 64 * (r / nblk); t.n0 = 64 * (r % nblk);
    return t;
}
__device__ __forceinline__ void t_load(const TItem& t, f32x4 (&v)[16], f32x4 (&sc)[2], int lane) {
    const int lr = lane >> 4, c4 = lane & 15;
#pragma unroll
    for (int i = 0; i < 16; ++i) v[i] = *(const f32x4*)(t.W + (size_t)(t.k0 + 4 * i + lr) * t.N + t.n0 + c4 * 4);
    const float* ksp = (t.ks ? t.ks : t.dummy) + t.k0 + 8 * (lane & 7); const float use = t.ks ? 1.f : 0.f, one = 1.f - use;
    sc[0] = *(const f32x4*)(ksp) * use + one; sc[1] = *(const f32x4*)(ksp + 4) * use + one;
}
__device__ __forceinline__ void t_store(const TItem& t, f32x4 (&v)[16], const f32x4 (&sc)[2], LAS float* scr, int lane) {
    const int lr = lane >> 4, c4 = lane & 15;
#pragma unroll
    for (int i = 0; i < 16; ++i) {
        const int kk = 4 * i + lr;
        *(LAS f32x4*)(scr + kk * 64 + ((c4 ^ ((kk >> 3) & 7)) << 2)) = v[i];
    }
    asm volatile("s_waitcnt lgkmcnt(0)" ::: "memory");
    const int n0 = t.n0, seg3 = n0 >> 9, dseg3 = seg3 < 2 ? seg3 : seg3 == 2 ? 5 : seg3 == 3 ? 2 : seg3 == 4 ? 3 : seg3 == 5 ? 6 : 4;
    const int rbase = t.rowmode == 0 ? n0 : t.rowmode == 3 ? dseg3 * 512 + (n0 & 511) : (n0 >> 7) * 256 + (n0 & 127) + (t.rowmode == 2 ? 128 : 0);
    const int c = lane & 7;
#pragma unroll
    for (int j = 0; j < 8; ++j) {
        const int n = (lane >> 3) + 8 * j;
        const LAS float* s = scr + (8 * c) * 64 + ((((n >> 2) ^ c) << 2) | (n & 3));
        u32x4 o; o.x = pk2(s[0] * sc[0][0], s[64] * sc[0][1]); o.y = pk2(s[128] * sc[0][2], s[192] * sc[0][3]); o.z = pk2(s[256] * sc[1][0], s[320] * sc[1][1]); o.w = pk2(s[384] * sc[1][2], s[448] * sc[1][3]);
        *(u32x4*)(t.WT + (size_t)(rbase + n) * t.K + t.k0 + 8 * c) = o;
    }
    asm volatile("s_waitcnt lgkmcnt(0)" ::: "memory");
}
__device__ __forceinline__ void t_load8(const TItem& t, f32x4 (&v)[16], f32x4 (&sc)[4], int lane) {
    const int lr = lane >> 4, c4 = lane & 15;
#pragma unroll
    for (int i = 0; i < 16; ++i) v[i] = *(const f32x4*)(t.W + (size_t)(t.k0 + 4 * i + lr) * t.N + t.n0 + c4 * 4);
#pragma unroll
    for (int q = 0; q < 4; ++q) sc[q] = *(const f32x4*)((t.ks ? t.ks : t.dummy) + t.k0 + 16 * (lane & 3) + 4 * q);
}
__device__ __forceinline__ void t_store8(const TItem& t, f32x4 (&v)[16], const f32x4 (&sc)[4], LAS float* scr, int lane) {
    const int lr = lane >> 4, c4 = lane & 15;
#pragma unroll
    for (int i = 0; i < 16; ++i) {
        const int kk = 4 * i + lr;
        *(LAS f32x4*)(scr + kk * 64 + ((c4 ^ ((kk >> 3) & 7)) << 2)) = v[i];
    }
    asm volatile("s_waitcnt lgkmcnt(0)" ::: "memory");
    const int n0 = t.n0;
    const int rbase = t.rowmode == 0 ? n0 : (n0 >> 7) * 256 + (n0 & 127) + (t.rowmode == 2 ? 128 : 0);
    const float ksu = t.ks ? t.wscale : 0.f, ksc = t.ks ? 0.f : t.wscale;
    const int c = lane & 3;
#pragma unroll
    for (int j = 0; j < 4; ++j) {
        const int n = (lane >> 2) + 16 * j;
        float w[16];
#pragma unroll
        for (int q = 0; q < 16; ++q) { const int sw = (2 * c + (q >> 3)) & 7; w[q] = scr[(16 * c + q) * 64 + ((((n >> 2) ^ sw) << 2) | (n & 3))] * (sc[q >> 2][q & 3] * ksu + ksc); }
        const u32x4 o = {pk4_fp8(w[0], w[1], w[2], w[3]), pk4_fp8(w[4], w[5], w[6], w[7]), pk4_fp8(w[8], w[9], w[10], w[11]), pk4_fp8(w[12], w[13], w[14], w[15])};
        *(u32x4*)(t.WT8 + (size_t)(rbase + n) * t.K + t.k0 + 16 * c) = o;
    }
    asm volatile("s_waitcnt lgkmcnt(0)" ::: "memory");
}
constexpr int T_NITEMS = 16 * (INC / 64) + 2 * 256 + 64 + NE * (2 * 128 + 128), T_DENSE_ITEMS = 16 * (INC / 64) + 2 * 256 + 64;
template <bool F8>
__device__ __forceinline__ void ph_prep_weights(const P& p, LAS unsigned char* lds, int bid, int nb, int lo, int hi, int w0, int nw) {
    const int tid = phase_tid(), wave = __builtin_amdgcn_readfirstlane(tid >> 6), lane = tid & 63;
    if (wave < w0 || wave >= w0 + nw) return;
    LAS float* scr = (LAS float*)(lds + wave * 16384);
    const int gw = bid * nw + (wave - w0), ngw = nb * nw;
    f32x4 va[16], vb[16], sa[4], sb[4];
    int it = lo + gw;
    if (it >= hi) return;
    TItem ta = t_decode(p, it), tb = ta;
#define T_LOAD(t, v, s) do { if constexpr (F8) t_load8(t, v, s, lane); else t_load(t, v, (f32x4(&)[2])s, lane); } while (0)
#define T_STORE(t, v, s) do { if constexpr (F8) t_store8(t, v, s, scr, lane); else t_store(t, v, (const f32x4(&)[2])s, scr, lane); } while (0)
    T_LOAD(ta, va, sa);
    __builtin_amdgcn_sched_barrier(0);
    for (; it < hi; it += 2 * ngw) {
        const int i1 = it + ngw, i2 = it + 2 * ngw;
        tb = t_decode(p, i1 < hi ? i1 : it); T_LOAD(tb, vb, sb);
        __builtin_amdgcn_sched_barrier(0);
        T_STORE(ta, va, sa);
        ta = t_decode(p, i2 < hi ? i2 : it); T_LOAD(ta, va, sa);
        __builtin_amdgcn_sched_barrier(0);
        if (i1 < hi) T_STORE(tb, vb, sb);
    }
#undef T_LOAD
#undef T_STORE
}

__device__ __forceinline__ void ph_prep_router(const P& p, int bid, int nb) {
    for (int i = bid * NT + threadIdx.x; i < 96 * DM; i += nb * NT) {
        const int row = i >> 10, k = i & 1023, tau = row >> 5, rho = row & 31;
        float v = 0.f;
        if ((rho & 4) == 0) {
            const int r = (rho & 3) + 4 * (rho >> 3), L = tau * 16 + r;
            if (L < 4) v = p.ffn_w[k] * p.wgr[k * 4 + L]; else if (L < 36) v = p.ffn_w[k] * p.wer[k * 32 + L - 4];
        }
        p.wrt()[i] = f2bf(v);
    }
}

__device__ __forceinline__ void moe_fill_tables(const P& p, const MoeTab* T, LAS unsigned char* lds, int bid, int nb) {
    LAS int* gtab = (LAS int*)(lds + GTAB_OFF); LAS float* rtab = (LAS float*)(lds + GTAB_OFF + GTAB_UNITS * 1024); LAS int* ud = (LAS int*)(lds + UDESC_OFF);
    const int tid = phase_tid();
    for (int i = 0; i < GTAB_UNITS; ++i) {
        int mt, pn;
        if (!moe_unit(T, i, bid, nb, mt, pn)) { if (tid == 0) ud[4 * i + 1] = 0; continue; }
        int e = 0; while (T->tpre[e + 1] <= mt) ++e;
        const int r0 = (mt - T->tpre[e]) * 256, cnt = T->cnt[e], rem = cnt - r0;
        if (tid == 0) { ud[4 * i] = T->off[e] + r0; ud[4 * i + 1] = rem < 256 ? rem : 256; ud[4 * i + 2] = e; ud[4 * i + 3] = pn; }
        if (tid < 256) {
            int rk = r0 + tid; if (rk >= cnt) rk = cnt - 1;
            const int tok = p.list()[e * M + rk];
            gtab[i * 256 + tid] = tok; rtab[i * 256 + tid] = p.rstd1()[tok];
        }
    }
    __syncthreads();
}

typedef short bf16x8 __attribute__((ext_vector_type(8)));
typedef float f32x16 __attribute__((ext_vector_type(16)));
constexpr int SB_STG_PITCH = 68, SB_STG_BYTES = 32 * SB_STG_PITCH * 4;
__device__ __forceinline__ float partner32(float x, int hi) {
    const unsigned xb = __float_as_uint(x);
    const auto rr = __builtin_amdgcn_permlane32_swap(xb, xb, false, false);
    (void)hi;
    return __uint_as_float(rr[0] != xb ? rr[0] : rr[1]);
}
#define SB_WAIT_V(n) asm volatile("s_waitcnt vmcnt(" #n ")" ::: "memory")
__device__ __forceinline__ void sb_dma_tile(const bf16* g, size_t row_pitch, LAS unsigned char* l, int lane) {
    const int p = lane & 7;
#pragma unroll
    for (int i = 0; i < 8; ++i) {
        const int row = 8 * i + (lane >> 3), c = p ^ ((row >> 1) & 7);
        __builtin_amdgcn_global_load_lds((const unsigned*)(g + (size_t)row * row_pitch + c * 8), (LAS unsigned*)(l + i * 1024), 16, 0, 0);
    }
}
__device__ __forceinline__ void sb_unit(const P& p, LAS unsigned char* wl, int b, int h, int qblk, int lane) {
    const int r32 = lane & 31, hi = lane >> 5, q0 = qblk * 32, swr = (r32 >> 1) & 7;
    const size_t tok0 = (size_t)b * SEQ;
    const bf16* Kg = p.sbk() + tok0 * 512 + h * 64;
    const bf16* Vg = p.vt() + (size_t)(h * 64) * M + tok0;
    LAS unsigned char* kl = wl; LAS unsigned char* vl = wl + 8192;
    const int jdiag = (q0 + 31) >> 6;
    sb_dma_tile(Kg + (size_t)jdiag * 64 * 512, 512, kl, lane);
    sb_dma_tile(Vg + jdiag * 64, M, vl, lane);
    bf16x8 qf[4];
    {
        const bf16* Qp = p.sbq() + (tok0 + q0 + r32) * 512 + h * 64 + hi * 8;
#pragma unroll
        for (int d0 = 0; d0 < 4; ++d0) qf[d0] = *(const bf16x8*)(Qp + d0 * 16);
    }
    f32x16 o0, o1;
#pragma unroll
    for (int r = 0; r < 16; ++r) { o0[r] = 0.f; o1[r] = 0.f; }
    float C = 1.0f;
    const int t = q0 + r32;
    const LAS unsigned char* kr = kl + r32 * 128; const LAS unsigned char* vr = vl + r32 * 128 + hi * 8;
    for (int jt = jdiag; jt >= 0; --jt) {
        const int kv0 = jt * 64, jn = jt > 0 ? jt - 1 : 0;
        SB_WAIT_V(8);
        bf16x8 kf[8];
#pragma unroll
        for (int d0 = 0; d0 < 4; ++d0) {
            kf[2 * d0] = *(const LAS bf16x8*)(kr + (((2 * d0 + hi) ^ swr) << 4));
            kf[2 * d0 + 1] = *(const LAS bf16x8*)(kr + 32 * 128 + (((2 * d0 + hi) ^ swr) << 4));
        }
        f32x16 p0, p1;
#pragma unroll
        for (int r = 0; r < 16; ++r) { p0[r] = 0.f; p1[r] = 0.f; }
#pragma unroll
        for (int d0 = 0; d0 < 4; ++d0) {
            p0 = __builtin_amdgcn_mfma_f32_32x32x16_bf16(kf[2 * d0], qf[d0], p0, 0, 0, 0);
            p1 = __builtin_amdgcn_mfma_f32_32x32x16_bf16(kf[2 * d0 + 1], qf[d0], p1, 0, 0, 0);
        }
        asm volatile("s_waitcnt lgkmcnt(0)" ::: "memory");
        sb_dma_tile(Kg + (size_t)jn * 64 * 512, 512, kl, lane);
        f32x16 b0, b1;
#pragma unroll
        for (int r = 0; r < 16; ++r) {
            const float e0 = __builtin_amdgcn_exp2f(p0[r]), e1 = __builtin_amdgcn_exp2f(p1[r]);
            const float r0 = __builtin_amdgcn_rcpf(1.0f + e0), r1 = __builtin_amdgcn_rcpf(1.0f + e1);
            p0[r] = r0; p1[r] = r1; b0[r] = 1.0f - r0; b1[r] = 1.0f - r1;
        }
        if (jt == jdiag) {
#pragma unroll
            for (int r = 0; r < 16; ++r) {
                const int kv = kv0 + (r & 3) + 8 * (r >> 2) + 4 * hi;
                if (kv >= t) { p0[r] = 1.0f; b0[r] = 0.f; }
                if (kv + 32 >= t) { p1[r] = 1.0f; b1[r] = 0.f; }
            }
        }
        float T[8], X[8];
#pragma unroll
        for (int i = 0; i < 4; ++i) { T[i] = (p0[4 * i] * p0[4 * i + 1]) * (p0[4 * i + 2] * p0[4 * i + 3]); T[4 + i] = (p1[4 * i] * p1[4 * i + 1]) * (p1[4 * i + 2] * p1[4 * i + 3]); }
        float suf = 1.0f;
#pragma unroll
        for (int i = 7; i >= 0; --i) {
            const float part = partner32(T[i], hi);
            X[i] = (hi ? suf : suf * part) * C;
            suf *= T[i] * part;
        }
        C *= suf;
#pragma unroll
        for (int i = 0; i < 4; ++i) {
            float w = X[i];
            b0[4 * i + 3] *= w; w *= p0[4 * i + 3]; b0[4 * i + 2] *= w; w *= p0[4 * i + 2]; b0[4 * i + 1] *= w; w *= p0[4 * i + 1]; b0[4 * i] *= w;
            w = X[4 + i];
            b1[4 * i + 3] *= w; w *= p1[4 * i + 3]; b1[4 * i + 2] *= w; w *= p1[4 * i + 2]; b1[4 * i + 1] *= w; w *= p1[4 * i + 1]; b1[4 * i] *= w;
        }
        u32x4 pa[4];
#pragma unroll
        for (int s = 0; s < 2; ++s) {
            pa[s] = (u32x4){pk2(b0[8 * s], b0[8 * s + 1]), pk2(b0[8 * s + 2], b0[8 * s + 3]), pk2(b0[8 * s + 4], b0[8 * s + 5]), pk2(b0[8 * s + 6], b0[8 * s + 7])};
            pa[2 + s] = (u32x4){pk2(b1[8 * s], b1[8 * s + 1]), pk2(b1[8 * s + 2], b1[8 * s + 3]), pk2(b1[8 * s + 4], b1[8 * s + 5]), pk2(b1[8 * s + 6], b1[8 * s + 7])};
        }
        SB_WAIT_V(8);
#pragma unroll
        for (int s = 0; s < 4; ++s) {
            const u32x2 l0 = *(const LAS u32x2*)(vr + (((2 * s) ^ swr) << 4)), h0 = *(const LAS u32x2*)(vr + (((2 * s + 1) ^ swr) << 4));
            const u32x2 l1 = *(const LAS u32x2*)(vr + 32 * 128 + (((2 * s) ^ swr) << 4)), h1 = *(const LAS u32x2*)(vr + 32 * 128 + (((2 * s + 1) ^ swr) << 4));
            const u32x4 v0 = {l0.x, l0.y, h0.x, h0.y}, v1 = {l1.x, l1.y, h1.x, h1.y};
            o0 = __builtin_amdgcn_mfma_f32_32x32x16_bf16(__builtin_bit_cast(bf16x8, pa[s]), __builtin_bit_cast(bf16x8, v0), o0, 0, 0, 0);
            o1 = __builtin_amdgcn_mfma_f32_32x32x16_bf16(__builtin_bit_cast(bf16x8, pa[s]), __builtin_bit_cast(bf16x8, v1), o1, 0, 0, 0);
        }
        asm volatile("s_waitcnt lgkmcnt(0)" ::: "memory");
        sb_dma_tile(Vg + jn * 64, M, vl, lane);
        if (__all(C == 0.0f)) break;
    }
    SB_WAIT_V(0);
    f32x4 nw[8];
    { const float* wv = p.sb_w + h * 64 + (lane & 1) * 32;
#pragma unroll
      for (int j = 0; j < 8; ++j) nw[j] = *(const f32x4*)(wv + 4 * j); }
    LAS float* stg = (LAS float*)wl;
#pragma unroll
    for (int r = 0; r < 16; ++r) { const int row = (r & 3) + 8 * (r >> 2) + 4 * hi; stg[row * SB_STG_PITCH + r32] = o0[r]; stg[row * SB_STG_PITCH + 32 + r32] = o1[r]; }
    asm volatile("s_waitcnt lgkmcnt(0)" ::: "memory");
    {
        const int row = lane >> 1, half = lane & 1;
        f32x4 v[8]; float ss = 0.f;
#pragma unroll
        for (int j = 0; j < 8; ++j) { v[j] = *(const LAS f32x4*)(stg + row * SB_STG_PITCH + half * 32 + 4 * j); ss += v[j][0] * v[j][0] + v[j][1] * v[j][1] + v[j][2] * v[j][2] + v[j][3] * v[j][3]; }
        ss += __shfl_xor(ss, 1);
        const float rs = rsqrtf(ss * (1.0f / 64) + EPS);
        bf16* mo = p.mix() + (tok0 + q0 + row) * DM + h * 64 + half * 32;
#pragma unroll
        for (int j = 0; j < 4; ++j) *(u32x4*)(mo + 8 * j) = pack8(v[2 * j] * rs * nw[2 * j], v[2 * j + 1] * rs * nw[2 * j + 1]);
    }
    asm volatile("s_waitcnt lgkmcnt(0)" ::: "memory");
}
constexpr int SB_WAVES = 6;
__device__ __forceinline__ void ph_sb(const P& p, LAS unsigned char* lds, int bid, int nb) {
    const int tid = phase_tid(), wid = __builtin_amdgcn_readfirstlane(tid >> 6), lane = tid & 63;
    if (wid >= SB_WAVES) return;
    LAS unsigned char* wl = lds + wid * 16384;
    for (int x = bid; x < 256; x += nb) {
        const int bh = x & 63, g = x >> 6;
#pragma unroll 1
        for (int u = wid; u < 32; u += SB_WAVES) {
            const int uq = u >> 3, grp = uq == 0 ? g : uq == 1 ? 7 - g : uq == 2 ? 8 + g : 15 - g;
            sb_unit(p, wl, bh >> 3, bh & 7, grp * 8 + (u & 7), lane);
        }
    }
}
#undef SB_WAIT_V

constexpr int HG_TOT = 0, HG_KUT = 4096, HG_KUT_PITCH = 144, HG_UST = 24576;
constexpr int HG_PITCH = 272, HG_QH = 4096, HG_QI = HG_QH + 64 * HG_PITCH, HG_KH = HG_QI + 64 * HG_PITCH, HG_OST = HG_KH + 64 * HG_PITCH, HG_OST_PITCH = 132;
__device__ __forceinline__ void hg_cumsum(const unsigned (&g)[8], LAS unsigned char* lds, int ch2, int oct, float (&bc0)[8], float (&bc1)[8], float& bl0, float& bl1, float& br0, float& br1) {
    float a0 = 0.f, a1 = 0.f;
#pragma unroll
    for (int i = 0; i < 8; ++i) { typedef _Float16 f16x2 __attribute__((ext_vector_type(2))); const f16x2 gh = __builtin_bit_cast(f16x2, g[i]); a0 += (float)gh.x; a1 += (float)gh.y; bc0[i] = a0; bc1[i] = a1; }
    LAS float* TOT = (LAS float*)(lds + HG_TOT);
    *(LAS f32x2*)(TOT + oct * 128 + ch2) = (f32x2){a0, a1};
    __syncthreads();
    float of0 = 0.f, of1 = 0.f; bl0 = 0.f; bl1 = 0.f; br0 = 0.f; br1 = 0.f;
#pragma unroll
    for (int o = 0; o < 8; ++o) {
        const f32x2 tv = *(const LAS f32x2*)(TOT + o * 128 + ch2);
        if (o < oct) { of0 += tv.x; of1 += tv.y; }
        if (o < 4) { br0 += tv.x; br1 += tv.y; }
        bl0 += tv.x; bl1 += tv.y;
    }
#pragma unroll
    for (int i = 0; i < 8; ++i) { bc0[i] += of0; bc1[i] += of1; }
}
__device__ __forceinline__ float fexp(float x) { return __builtin_amdgcn_exp2f(1.4426950408889634f * x); }

__device__ __forceinline__ void ph_hg_state(const P& p, LAS unsigned char* lds, int bid, int nb) {
    const int tid = phase_tid(), wid = __builtin_amdgcn_readfirstlane(tid >> 6), lane = tid & 63, r32 = lane & 31, hi = lane >> 5;
    const int ch2 = lane * 2, oct = wid, vt = wid >> 1;
    bf16* U = (bf16*)p.out;
    constexpr int NU = BATCH * HGH * 64;
    unsigned g[8], kk[8]; bf16x8 af[4];
#define HGS_TOK0(un) ((size_t)(((un) >> 6) >> 2) * SEQ + ((un) & 63) * 64)
#define HGS_LOAD_A(un) do { const size_t t0_ = HGS_TOK0(un); const int h_ = ((un) >> 6) & 3; const _Float16* lf = p.logf() + t0_ * 512 + h_ * 128; \
        _Pragma("unroll") for (int i = 0; i < 8; ++i) g[i] = *(const unsigned*)(lf + (size_t)(oct * 8 + i) * 512 + ch2); \
        _Pragma("unroll") for (int i = 0; i < 8; ++i) kk[i] = *(const unsigned*)(p.hk() + (t0_ + oct * 8 + i) * 512 + h_ * 128 + ch2); } while (0)
#define HGS_LOAD_B(un) do { const size_t t0_ = HGS_TOK0(un); const int h_ = ((un) >> 6) & 3; const bf16* A = p.vt() + (size_t)(512 + h_ * 128 + vt * 32 + r32) * M + t0_ + hi * 8; \
        _Pragma("unroll") for (int ks = 0; ks < 4; ++ks) af[ks] = *(const bf16x8*)(A + ks * 16); } while (0)
    { const int u0 = bid < NU ? bid : 0; HGS_LOAD_A(u0); __builtin_amdgcn_sched_barrier(0); HGS_LOAD_B(u0); __builtin_amdgcn_sched_barrier(0); }
    for (int unit = bid; unit < NU; unit += nb) {
        const int nxt = unit + nb < NU ? unit + nb : unit;
        float bc0[8], bc1[8], bl0, bl1, br0, br1;
        hg_cumsum(g, lds, ch2, oct, bc0, bc1, bl0, bl1, br0, br1);
        float u0[8], u1[8];
#pragma unroll
        for (int i = 0; i < 8; ++i) { u0[i] = bflo(kk[i]) * fexp(bl0 - bc0[i]); u1[i] = bfhi(kk[i]) * fexp(bl1 - bc1[i]); }
        *(LAS u32x4*)(lds + HG_KUT + ch2 * HG_KUT_PITCH + oct * 16) = (u32x4){pk2(u0[0], u0[1]), pk2(u0[2], u0[3]), pk2(u0[4], u0[5]), pk2(u0[6], u0[7])};
        *(LAS u32x4*)(lds + HG_KUT + (ch2 + 1) * HG_KUT_PITCH + oct * 16) = (u32x4){pk2(u1[0], u1[1]), pk2(u1[2], u1[3]), pk2(u1[4], u1[5]), pk2(u1[6], u1[7])};
        if (oct == 0) *(f32x2*)(p.hgd() + (size_t)unit * 128 + ch2) = (f32x2){fexp(bl0), fexp(bl1)};
        __syncthreads();
        HGS_LOAD_A(nxt);
        f32x16 acc[2];
#pragma unroll
        for (int cl = 0; cl < 2; ++cl) {
            const int ct = (wid & 1) * 2 + cl;
#pragma unroll
            for (int r = 0; r < 16; ++r) acc[cl][r] = 0.f;
#pragma unroll
            for (int ks = 0; ks < 4; ++ks) {
                const bf16x8 bf = *(const LAS bf16x8*)(lds + HG_KUT + (ct * 32 + r32) * HG_KUT_PITCH + (ks * 16 + hi * 8) * 2);
                acc[cl] = __builtin_amdgcn_mfma_f32_32x32x16_bf16(af[ks], bf, acc[cl], 0, 0, 0);
            }
        }
        HGS_LOAD_B(nxt);
        { LAS float* st = (LAS float*)(lds + HG_UST + wid * SB_STG_BYTES);
#pragma unroll
          for (int cl = 0; cl < 2; ++cl)
#pragma unroll
              for (int r = 0; r < 16; ++r) st[((r & 3) + 8 * (r >> 2) + 4 * hi) * SB_STG_PITCH + cl * 32 + r32] = acc[cl][r];
          asm volatile("s_waitcnt lgkmcnt(0)" ::: "memory");
          const int row = lane >> 1, half = lane & 1;
          bf16* Uo = U + (size_t)unit * 16384 + (size_t)(vt * 32 + row) * 128 + (wid & 1) * 64 + half * 32;
#pragma unroll
          for (int j = 0; j < 4; ++j) {
              const f32x4 a = *(const LAS f32x4*)(st + row * SB_STG_PITCH + half * 32 + 8 * j), c2 = *(const LAS f32x4*)(st + row * SB_STG_PITCH + half * 32 + 8 * j + 4);
              *(u32x4*)(Uo + 8 * j) = pack8(a, c2);
          }
          asm volatile("s_waitcnt lgkmcnt(0)" ::: "memory"); }
    }
#undef HGS_LOAD_A
#undef HGS_LOAD_B
    __syncthreads();
}
__device__ __forceinline__ void ph_hg_scan(const P& p, int bid, int nb) {
    const bf16* U = (const bf16*)p.out;
    for (int e = bid * NT + threadIdx.x; e < BATCH * HGH * 4096; e += nb * NT) {
        const int bh = e >> 12, v = (e >> 5) & 127, c4 = (e & 31) * 4;
        f32x4 S = {0.f, 0.f, 0.f, 0.f};
        const size_t o0 = (size_t)bh * 64 * 16384 + (size_t)v * 128 + c4;
#pragma unroll 8
        for (int c = 0; c < 64; ++c) {
            const u32x2 uw = *(const u32x2*)(U + o0 + (size_t)c * 16384);
            const f32x4 u = {bflo(uw.x), bfhi(uw.x), bflo(uw.y), bfhi(uw.y)};
            const f32x4 d = *(const f32x4*)(p.hgd() + (size_t)(bh * 64 + c) * 128 + c4);
            u32x2 w; w.x = pk2(S[0], S[1]); w.y = pk2(S[2], S[3]);
            *(u32x2*)(p.sprev() + o0 + (size_t)c * 16384) = w;
            S = d * S + u;
        }
    }
}
__device__ __forceinline__ void ph_hg_out(const P& p, LAS unsigned char* lds, int bid, int nb) {
    const int tid = phase_tid(), wid = __builtin_amdgcn_readfirstlane(tid >> 6), lane = tid & 63, r32 = lane & 31, hi = lane >> 5;
    const int ch2 = lane * 2, oct = wid;
    const int tb = wid >> 2, vb = wid & 3;
    const int tn = tid >> 3, sg = tid & 7;
    constexpr int NU = BATCH * HGH * 64;
    unsigned g[8], qq[8], kk[8]; bf16x8 bS[8]; u32x2 vl[2][2], vh[2][2]; u32x4 g0, g1; f32x4 w0, w1, w2, w3;
#define HGO_LOAD_A(un) do { const size_t t0_ = HGS_TOK0(un); const int h_ = ((un) >> 6) & 3; const _Float16* lf = p.logf() + t0_ * 512 + h_ * 128; \
        _Pragma("unroll") for (int i = 0; i < 8; ++i) g[i] = *(const unsigned*)(lf + (size_t)(oct * 8 + i) * 512 + ch2); \
        _Pragma("unroll") for (int i = 0; i < 8; ++i) { const size_t gi = (t0_ + oct * 8 + i) * 512 + h_ * 128 + ch2; qq[i] = *(const unsigned*)(p.hq() + gi); kk[i] = *(const unsigned*)(p.hk() + gi); } } while (0)
#define HGO_LOAD_B(un) do { const size_t t0_ = HGS_TOK0(un); const int h_ = ((un) >> 6) & 3; \
        const bf16* Sp = p.sprev() + (size_t)(un) * 16384 + (size_t)(vb * 32 + r32) * 128 + hi * 8; \
        _Pragma("unroll") for (int ks = 0; ks < 8; ++ks) bS[ks] = *(const bf16x8*)(Sp + ks * 16); \
        const bf16* Vt = p.vt() + (size_t)(512 + h_ * 128 + vb * 32 + r32) * M + t0_ + hi * 4; \
        _Pragma("unroll") for (int sb = 0; sb < 2; ++sb) _Pragma("unroll") for (int k2 = 0; k2 < 2; ++k2) { vl[sb][k2] = *(const u32x2*)(Vt + sb * 32 + 16 * k2); vh[sb][k2] = *(const u32x2*)(Vt + sb * 32 + 16 * k2 + 8); } \
        const bf16* gp = p.hgate() + (t0_ + tn) * 512 + h_ * 128 + sg * 16; g0 = *(const u32x4*)(gp); g1 = *(const u32x4*)(gp + 8); \
        const float* wv_ = p.hg_w + h_ * 128 + sg * 16; w0 = *(const f32x4*)(wv_); w1 = *(const f32x4*)(wv_ + 4); w2 = *(const f32x4*)(wv_ + 8); w3 = *(const f32x4*)(wv_ + 12); } while (0)
    { const int u0 = bid < NU ? bid : 0; HGO_LOAD_A(u0); __builtin_amdgcn_sched_barrier(0); HGO_LOAD_B(u0); __builtin_amdgcn_sched_barrier(0); }
    for (int unit = bid; unit < NU; unit += nb) {
        const int nxt = unit + nb < NU ? unit + nb : unit;
        const int h = (unit >> 6) & 3;
        const size_t tok0 = HGS_TOK0(unit);
        float bc0[8], bc1[8], bl0, bl1, br0, br1;
        hg_cumsum(g, lds, ch2, oct, bc0, bc1, bl0, bl1, br0, br1);
#pragma unroll
        for (int i = 0; i < 8; ++i) {
            const int lo = (oct * 8 + i) * HG_PITCH + ch2 * 2;
            *(LAS unsigned*)(lds + HG_QH + lo) = pk2(bflo(qq[i]) * fexp(fminf(bc0[i] - br0, 80.f)), bfhi(qq[i]) * fexp(fminf(bc1[i] - br1, 80.f)));
            *(LAS unsigned*)(lds + HG_QI + lo) = pk2(bflo(qq[i]) * fexp(bc0[i]), bfhi(qq[i]) * fexp(bc1[i]));
            *(LAS unsigned*)(lds + HG_KH + lo) = pk2(bflo(kk[i]) * fexp(fminf(br0 - bc0[i], 80.f)), bfhi(kk[i]) * fexp(fminf(br1 - bc1[i], 80.f)));
        }
        __syncthreads();
        HGO_LOAD_A(nxt);
        f32x16 o;
#pragma unroll
        for (int r = 0; r < 16; ++r) o[r] = 0.f;
#pragma unroll
        for (int ks = 0; ks < 8; ++ks) {
            const bf16x8 a = *(const LAS bf16x8*)(lds + HG_QI + (tb * 32 + r32) * HG_PITCH + (ks * 16 + hi * 8) * 2);
            o = __builtin_amdgcn_mfma_f32_32x32x16_bf16(a, bS[ks], o, 0, 0, 0);
        }
#pragma unroll
        for (int sb = 0; sb < 2; ++sb) {
            if (sb <= tb) {
                f32x16 x;
#pragma unroll
                for (int r = 0; r < 16; ++r) x[r] = 0.f;
#pragma unroll
                for (int ks = 0; ks < 8; ++ks) {
                    const bf16x8 a = *(const LAS bf16x8*)(lds + HG_KH + (sb * 32 + r32) * HG_PITCH + (ks * 16 + hi * 8) * 2);
                    const bf16x8 bq = *(const LAS bf16x8*)(lds + HG_QH + (tb * 32 + r32) * HG_PITCH + (ks * 16 + hi * 8) * 2);
                    x = __builtin_amdgcn_mfma_f32_32x32x16_bf16(a, bq, x, 0, 0, 0);
                }
                if (sb == tb) {
#pragma unroll
                    for (int r = 0; r < 16; ++r) { const int sl = (r & 3) + 8 * (r >> 2) + 4 * hi; x[r] = sl <= r32 ? x[r] : 0.f; }
                }
#pragma unroll
                for (int k2 = 0; k2 < 2; ++k2) {
                    const u32x4 pa = {pk2(x[8 * k2], x[8 * k2 + 1]), pk2(x[8 * k2 + 2], x[8 * k2 + 3]), pk2(x[8 * k2 + 4], x[8 * k2 + 5]), pk2(x[8 * k2 + 6], x[8 * k2 + 7])};
                    const u32x4 vv = {vl[sb][k2].x, vl[sb][k2].y, vh[sb][k2].x, vh[sb][k2].y};
                    o = __builtin_amdgcn_mfma_f32_32x32x16_bf16(__builtin_bit_cast(bf16x8, pa), __builtin_bit_cast(bf16x8, vv), o, 0, 0, 0);
                }
            }
        }
        { LAS float* OST = (LAS float*)(lds + HG_OST);
#pragma unroll
          for (int r = 0; r < 16; ++r) OST[(tb * 32 + (r & 3) + 8 * (r >> 2) + 4 * hi) * HG_OST_PITCH + vb * 32 + r32] = o[r]; }
        __syncthreads();
        {
            const LAS float* orow = (const LAS float*)(lds + HG_OST) + tn * HG_OST_PITCH + sg * 16;
            f32x4 v[4]; float ss = 0.f;
#pragma unroll
            for (int j = 0; j < 4; ++j) { v[j] = *(const LAS f32x4*)(orow + 4 * j); ss += v[j][0] * v[j][0] + v[j][1] * v[j][1] + v[j][2] * v[j][2] + v[j][3] * v[j][3]; }
            ss += __shfl_xor(ss, 1); ss += __shfl_xor(ss, 2); ss += __shfl_xor(ss, 4);
            const float rs = rsqrtf(ss * (1.0f / 128) + EPS);
            const int col = h * 128 + sg * 16;
            const f32x4 ga = {bflo(g0.x), bfhi(g0.x), bflo(g0.y), bfhi(g0.y)}, gb = {bflo(g0.z), bfhi(g0.z), bflo(g0.w), bfhi(g0.w)};
            const f32x4 gc = {bflo(g1.x), bfhi(g1.x), bflo(g1.y), bfhi(g1.y)}, gd = {bflo(g1.z), bfhi(g1.z), bflo(g1.w), bfhi(g1.w)};
            const u32x4 r0 = pack8(v[0] * rs * w0 * ga, v[1] * rs * w1 * gb), r1 = pack8(v[2] * rs * w2 * gc, v[3] * rs * w3 * gd);
            HGO_LOAD_B(nxt);
            bf16* mo = p.mix() + (tok0 + tn) * DM + 512 + col;
            *(u32x4*)(mo) = r0; *(u32x4*)(mo + 8) = r1;
        }
    }
#undef HGO_LOAD_A
#undef HGO_LOAD_B
#undef HGS_TOK0
    __syncthreads();
}

__device__ __forceinline__ void ph_route(const P& p, int bid, int nb) {
    const int tid = phase_tid(), wid = __builtin_amdgcn_readfirstlane(tid >> 6), lane = tid & 63, r32 = lane & 31, hi = lane >> 5;
    if (wid >= 4) return;
    for (int wu = bid + nb * wid; wu < M / 32; wu += nb * 4) {
        const int m = wu * 32 + r32;
        const bf16* Bp = p.h1b() + (size_t)m * DM + hi * 8; const bf16* Ap = p.wrt() + (size_t)r32 * DM + hi * 8;
        f32x16 a0, a1, a2;
#pragma unroll
        for (int r = 0; r < 16; ++r) { a0[r] = 0.f; a1[r] = 0.f; a2[r] = 0.f; }
        float ss = 0.f;
#pragma unroll 8
        for (int ks = 0; ks < 64; ++ks) {
            const u32x4 bw = *(const u32x4*)(Bp + ks * 16);
            ss += bflo(bw.x) * bflo(bw.x) + bfhi(bw.x) * bfhi(bw.x) + bflo(bw.y) * bflo(bw.y) + bfhi(bw.y) * bfhi(bw.y) + bflo(bw.z) * bflo(bw.z) + bfhi(bw.z) * bfhi(bw.z) + bflo(bw.w) * bflo(bw.w) + bfhi(bw.w) * bfhi(bw.w);
            const bf16x8 b = __builtin_bit_cast(bf16x8, bw);
            a0 = __builtin_amdgcn_mfma_f32_32x32x16_bf16(*(const bf16x8*)(Ap + ks * 16), b, a0, 0, 0, 0);
            a1 = __builtin_amdgcn_mfma_f32_32x32x16_bf16(*(const bf16x8*)(Ap + 32 * DM + ks * 16), b, a1, 0, 0, 0);
            a2 = __builtin_amdgcn_mfma_f32_32x32x16_bf16(*(const bf16x8*)(Ap + 64 * DM + ks * 16), b, a2, 0, 0, 0);
        }
        ss += partner32(ss, hi);
        const float rs = rsqrtf(ss * (1.0f / DM) + EPS);
        float gl[4];
#pragma unroll
        for (int g = 0; g < 4; ++g) gl[g] = a0[g] * rs + p.bgr[g];
        int gi = 0; float best = gl[0];
#pragma unroll
        for (int g = 1; g < 4; ++g) if (gl[g] > best) { best = gl[g]; gi = g; }
        float den = 0.f;
#pragma unroll
        for (int g = 0; g < 4; ++g) den += expf(gl[g] - best);
        const float gprob = 1.0f / den;
        float ig[8], bsel[8];
#pragma unroll
        for (int e = 0; e < 8; ++e) bsel[e] = p.ber[gi * 8 + e];
#pragma unroll
        for (int e = 0; e < 8; ++e) {
            const float c0 = a0[4 + e];
            const float c1 = (e < 4 ? a0[(12 + e) & 15] : a1[(e - 4) & 15]);
            const float c2 = a1[4 + e];
            const float c3 = (e < 4 ? a1[(12 + e) & 15] : a2[(e - 4) & 15]);
            ig[e] = (gi == 0 ? c0 : gi == 1 ? c1 : gi == 2 ? c2 : c3) * rs + bsel[e];
        }
        int i1 = 0; float v1 = ig[0];
#pragma unroll
        for (int e = 1; e < 8; ++e) if (ig[e] > v1) { v1 = ig[e]; i1 = e; }
        int i2 = -1; float v2 = -INFINITY;
#pragma unroll
        for (int e = 0; e < 8; ++e) if (e != i1 && ig[e] > v2) { v2 = ig[e]; i2 = e; }
        const float e2 = expf(v2 - v1), g1 = gprob / (1.0f + e2), g2 = gprob * e2 / (1.0f + e2);
        const int ex1 = hi ? -1 : gi * 8 + i1, ex2 = hi ? -2 : gi * 8 + i2;
        int cnt_mine = 0, off1 = 0, off2 = 0;
        const unsigned long long below = (1ull << lane) - 1ull;
#pragma unroll 4
        for (int e = 0; e < NE; ++e) {
            const unsigned long long m1 = __ballot(ex1 == e), m2 = __ballot(ex2 == e);
            const int c1n = __popcll(m1), c2n = __popcll(m2);
            if (lane == e) cnt_mine = c1n + c2n;
            if (ex1 == e) off1 = __popcll(m1 & below);
            if (ex2 == e) off2 = c1n + __popcll(m2 & below);
        }
        int base = 0;
        if (lane < NE && cnt_mine > 0) base = (int)atomicAdd(&p.ctl()[CW_CNT + lane * CNT_STRIDE], (unsigned)cnt_mine);
        const int b1 = __shfl(base, ex1 & 31), b2 = __shfl(base, ex2 & 31);
        if (hi == 0) {
            p.toke()[2 * m] = ex1; p.toke()[2 * m + 1] = ex2; p.tokr()[2 * m] = b1 + off1; p.tokr()[2 * m + 1] = b2 + off2;
            p.gate()[2 * m] = g1; p.gate()[2 * m + 1] = g2; p.rstd1()[m] = rs;
            p.list()[ex1 * M + b1 + off1] = m; p.list()[ex2 * M + b2 + off2] = m;
        }
    }
}

__device__ void ph_combine(const P& p, const MoeTab* T, int bid, int nb) {
    const int tid = phase_tid(), wave = tid >> 6, lane = tid & 63;
    typedef float f32x2v __attribute__((ext_vector_type(2)));
    for (int m = bid * 8 + wave; m < M; m += nb * 8) {
        const int e0 = p.toke()[2 * m], e1 = p.toke()[2 * m + 1];
        const size_t p0 = (size_t)(T->off[e0] + p.tokr()[2 * m]), p1 = (size_t)(T->off[e1] + p.tokr()[2 * m + 1]);
        const float g0 = p.gate()[2 * m] * (1.0f / FP8_SY), g1 = p.gate()[2 * m + 1] * (1.0f / FP8_SY);
        const u32x4* hr = (const u32x4*)(p.h1b() + (size_t)m * DM);
        const u32x2* y0 = (const u32x2*)(p.y8() + p0 * DM); const u32x2* y1 = (const u32x2*)(p.y8() + p1 * DM);
        u32x4* ho = (u32x4*)(p.h2b() + (size_t)m * DM);
        float ss = 0.f;
#pragma unroll
        for (int j = 0; j < 2; ++j) {
            const u32x4 h = __builtin_nontemporal_load(&hr[lane + 64 * j]); const u32x2 a = __builtin_nontemporal_load(&y0[lane + 64 * j]), b = __builtin_nontemporal_load(&y1[lane + 64 * j]);
            const f32x2v a0 = __builtin_amdgcn_cvt_pk_f32_fp8(a.x, false), a1 = __builtin_amdgcn_cvt_pk_f32_fp8(a.x, true), a2 = __builtin_amdgcn_cvt_pk_f32_fp8(a.y, false), a3 = __builtin_amdgcn_cvt_pk_f32_fp8(a.y, true);
            const f32x2v b0 = __builtin_amdgcn_cvt_pk_f32_fp8(b.x, false), b1 = __builtin_amdgcn_cvt_pk_f32_fp8(b.x, true), b2 = __builtin_amdgcn_cvt_pk_f32_fp8(b.y, false), b3 = __builtin_amdgcn_cvt_pk_f32_fp8(b.y, true);
            f32x4 v0, v1;
            v0[0] = bflo(h.x) + (g0 * a0[0] + g1 * b0[0]); v0[1] = bfhi(h.x) + (g0 * a0[1] + g1 * b0[1]);
            v0[2] = bflo(h.y) + (g0 * a1[0] + g1 * b1[0]); v0[3] = bfhi(h.y) + (g0 * a1[1] + g1 * b1[1]);
            v1[0] = bflo(h.z) + (g0 * a2[0] + g1 * b2[0]); v1[1] = bfhi(h.z) + (g0 * a2[1] + g1 * b2[1]);
            v1[2] = bflo(h.w) + (g0 * a3[0] + g1 * b3[0]); v1[3] = bfhi(h.w) + (g0 * a3[1] + g1 * b3[1]);
            ss += v0[0] * v0[0] + v0[1] * v0[1] + v0[2] * v0[2] + v0[3] * v0[3] + v1[0] * v1[0] + v1[1] * v1[1] + v1[2] * v1[2] + v1[3] * v1[3];
            ho[lane + 64 * j] = pack8(v0, v1);
        }
        ss = wave_sum(ss);
        if (lane == 0) p.rstd2()[m] = rsqrtf(ss * (1.0f / DM) + EPS);
    }
}
__device__ void ph_final(const P& p, int bid, int nb) {
    const int tid = phase_tid(), wave = tid >> 6, lane = tid & 63;
    for (int m = bid * 8 + wave; m < M; m += nb * 8) {
        const u32x4* hr = (const u32x4*)(p.h3b() + (size_t)m * DM);
        f32x4 v[4]; float ss = 0.f;
#pragma unroll
        for (int j = 0; j < 2; ++j) {
            const u32x4 h = __builtin_nontemporal_load(&hr[lane + 64 * j]);
            v[2 * j] = (f32x4){bflo(h.x), bfhi(h.x), bflo(h.y), bfhi(h.y)}; v[2 * j + 1] = (f32x4){bflo(h.z), bfhi(h.z), bflo(h.w), bfhi(h.w)};
        }
#pragma unroll
        for (int j = 0; j < 4; ++j) ss += v[j][0] * v[j][0] + v[j][1] * v[j][1] + v[j][2] * v[j][2] + v[j][3] * v[j][3];
        ss = wave_sum(ss);
        const float r = rsqrtf(ss * (1.0f / DM) + EPS);
        f32x4* orow = (f32x4*)(p.out + (size_t)m * DM);
#pragma unroll
        for (int j = 0; j < 2; ++j) {
            const f32x4 w0 = *(const f32x4*)(p.fin_w + (lane + 64 * j) * 8), w1 = *(const f32x4*)(p.fin_w + (lane + 64 * j) * 8 + 4);
            __builtin_nontemporal_store(v[2 * j] * r * w0, &orow[(lane + 64 * j) * 2]); __builtin_nontemporal_store(v[2 * j + 1] * r * w1, &orow[(lane + 64 * j) * 2 + 1]);
        }
    }
}

constexpr int CW_BAR = 4096;
constexpr size_t CTL_ZERO_BYTES = 64 * 1024;

__global__ void __launch_bounds__(NT, 2) fwd_megakernel(P p) {
    extern __shared__ __attribute__((aligned(16))) unsigned char lds_raw[];
    LAS unsigned char* lds3 = (LAS unsigned char*)lds_raw;
    volatile LAS unsigned* MISC = (volatile LAS unsigned*)(lds3 + MISC_OFF);
    MoeTab* T = (MoeTab*)(lds_raw + TAB_OFF);
    if (threadIdx.x < 32) MISC[threadIdx.x] = 0u;
    __syncthreads();
    XcdBarrier bar = xcd_barrier_post(p.ctl() + CW_BAR, MISC + 8);
    const int bid = blockIdx.x, nb = gridDim.x;
    ph_prep_weights<false>(p, lds3, bid, nb, 0, T_DENSE_ITEMS, 0, 8);
    ph_prep_router(p, bid, nb);
    ph_prep_rows(p, bid, nb);
    xcd_barrier(bar);
    { pg8::DenseOrder S; S.init(p.xn(), p.win(), M, INC - 1024, DM, nb, bid); EpiInProj E{p}; pg8::gemm_phase(lds3, DM, S, E); }
    { pg8::DenseOrder S; S.init(p.win() + (size_t)(INC - 1024) * DM, p.xn(), 1024, M, DM, nb, bid); EpiVT E{p}; pg8::gemm_phase(lds3, DM, S, E); }
    xcd_barrier(bar);
    ph_hg_state(p, lds3, bid, nb);
    ph_sb(p, lds3, bid, nb);
    ph_prep_weights<true>(p, lds3, bid, nb, T_DENSE_ITEMS, T_NITEMS, SB_WAVES, 8 - SB_WAVES);
    xcd_barrier(bar);
    ph_hg_scan(p, bid, nb);
    xcd_barrier(bar);
    ph_hg_out(p, lds3, bid, nb);
    xcd_barrier(bar);
    { pg8::DenseOrder S; S.init(p.mix(), p.wout(), M, DM, DM, nb, bid); EpiOutProj E{p}; pg8::gemm_phase(lds3, DM, S, E); }
    xcd_barrier(bar);
    ph_route(p, bid, nb);
    xcd_barrier(bar);
    moe_tab(p, T);
    moe_fill_tables(p, T, lds3, bid, nb);
    { MoeOrder S{(const LAS int*)(lds3 + UDESC_OFF), (const char*)p.h1q(), (const char*)p.wgu8(), (size_t)DM, (size_t)DM * DM, (size_t)256 * DM}; EpiMoeUp E{p, (const LAS float*)(lds3 + GTAB_OFF + GTAB_UNITS * 1024)};
      int k8 = DM / 2; asm volatile("" : "+s"(k8));
      pg8::gemm_phase<true, true>(lds3, k8, S, E, (const char*)p.h1q(), (const LAS int*)(lds3 + GTAB_OFF)); }
    xcd_barrier(bar);
    { MoeOrder S{(const LAS int*)(lds3 + UDESC_OFF), (const char*)p.act8(), (const char*)p.wd8(), (size_t)DE, (size_t)DM * DE, (size_t)256 * DE}; EpiMoeDown E{p}; int k8 = DE / 2; asm volatile("" : "+s"(k8)); pg8::gemm_phase<false, true>(lds3, k8, S, E); }
    xcd_barrier(bar);
    ph_combine(p, T, bid, nb);
    xcd_barrier(bar);
    { int kple = PLE; asm volatile("" : "+s"(kple)); pg8::DenseOrder S; S.init(p.pb(), p.wpp_t(), M, DM, kple, nb, bid); EpiPleE E{p}; pg8::gemm_phase(lds3, kple, S, E); }
    { pg8::DenseOrder S; S.init(p.h2b(), p.wpg_t(), M, DM, DM, nb, bid); EpiPleGate E{p}; pg8::gemm_phase(lds3, DM, S, E); }
    xcd_barrier(bar);
    ph_final(p, bid, nb);
}

extern "C" void kernel_launch(void* const* d_in, const int* in_sizes, int n_in, void* d_out, int out_size, void* d_ws, size_t ws_size, hipStream_t stream) {
    if (n_in != 20 || out_size != M * DM || ws_size < WS_END) { fprintf(stderr, "kernel_launch: unexpected shapes (n_in %d, out %d, ws %zu)\n", n_in, out_size, ws_size); return; }
    P p{};
    const float** f = (const float**)&p;
    for (int i = 0; i < 20; ++i) f[i] = (const float*)d_in[i];
    unsigned char* ws = (unsigned char*)d_ws;
    p.out = (float*)d_out; p.ws = ws;
    static int grid = 0;
    if (grid == 0) {
        int dev = 0, cus = 0, per_cu = 0;
        if (hipGetDevice(&dev) != hipSuccess || hipDeviceGetAttribute(&cus, hipDeviceAttributeMultiprocessorCount, dev) != hipSuccess) { fprintf(stderr, "kernel_launch: device query failed\n"); grid = -1; return; }
        if (hipFuncSetAttribute((const void*)fwd_megakernel, hipFuncAttributeMaxDynamicSharedMemorySize, LDS_BYTES) != hipSuccess) { fprintf(stderr, "kernel_launch: hipFuncSetAttribute failed\n"); grid = -1; return; }
        if (hipOccupancyMaxActiveBlocksPerMultiprocessor(&per_cu, (const void*)fwd_megakernel, NT, LDS_BYTES) != hipSuccess || per_cu < 1) { fprintf(stderr, "kernel_launch: occupancy query reports %d workgroups per CU\n", per_cu); }
        (void)hipGetLastError();
        grid = cus;
    }
    if (grid < 0) return;
    if (hipMemsetAsync(ws + WS_CTL, 0, CTL_ZERO_BYTES, stream) != hipSuccess) { fprintf(stderr, "kernel_launch: memset failed\n"); return; }
    hipLaunchKernelGGL(fwd_megakernel, dim3(grid), dim3(NT), LDS_BYTES, stream, p);
}
```

```cpp
#include <hip/hip_runtime.h>
#include <cstdio>
#include <cstdint>


constexpr int BATCH = 8, SEQ = 4096, DM = 1024, M = BATCH * SEQ;
constexpr int SBW = 512, SBH = 8, SBD = 64;
constexpr int HGW = 512, HGH = 4, HGD = 128;
constexpr int PLE = 256, NG = 4, EPG = 8, NE = 32, DE = 512, INC = 3584;
constexpr float EPS = 1e-6f;
constexpr int NT = 512;

typedef unsigned short bf16;
__device__ __forceinline__ bf16 f2bf(float f) { unsigned u = __float_as_uint(f); return (bf16)((u + 0x7fffu + ((u >> 16) & 1u)) >> 16); }
__device__ __forceinline__ float bf2f(bf16 h) { return __uint_as_float(((unsigned)h) << 16); }
__device__ __forceinline__ float bflo(unsigned w) { return __uint_as_float(w << 16); }
__device__ __forceinline__ float bfhi(unsigned w) { return __uint_as_float(w & 0xffff0000u); }
typedef float f32x2_t __attribute__((ext_vector_type(2))); typedef __bf16 bf16x2_t __attribute__((ext_vector_type(2)));
__device__ __forceinline__ unsigned pk2(float lo, float hi) { const f32x2_t v = {lo, hi}; const bf16x2_t b = __builtin_convertvector(v, bf16x2_t); return __builtin_bit_cast(unsigned, b); }
__device__ __forceinline__ int phase_tid() { int t = threadIdx.x; asm volatile("" : "+v"(t)); return t; }
constexpr float FP8_SH = 16.f, FP8_SW1 = 512.f, FP8_SA = 16.f, FP8_SW2 = 256.f, FP8_SY = 32.f;
__device__ __forceinline__ unsigned pk4_fp8(float a, float b, float c, float d) {
    a = __builtin_amdgcn_fmed3f(a, -448.f, 448.f); b = __builtin_amdgcn_fmed3f(b, -448.f, 448.f); c = __builtin_amdgcn_fmed3f(c, -448.f, 448.f); d = __builtin_amdgcn_fmed3f(d, -448.f, 448.f);
    unsigned w = 0; w = __builtin_amdgcn_cvt_pk_fp8_f32(a, b, w, false); w = __builtin_amdgcn_cvt_pk_fp8_f32(c, d, w, true); return w;
}
__device__ __forceinline__ float wave_sum(float v) {
#pragma unroll
    for (int o = 1; o < 64; o <<= 1) v += __shfl_xor(v, o);
    return v;
}
__device__ __forceinline__ float sigmoidf_(float x) { return 1.0f / (1.0f + expf(-x)); }

constexpr size_t MiB = 1u << 20;
constexpr size_t WS_CTL = 0;
constexpr size_t WS_LB = 1 * MiB;
constexpr size_t WS_RSTD1 = 1 * MiB + 64 * 1024;
constexpr size_t WS_RSTD2 = 1 * MiB + 256 * 1024;
constexpr size_t WS_TOKE = 2 * MiB;
constexpr size_t WS_TOKR = 2 * MiB + 512 * 1024;
constexpr size_t WS_GATE = 3 * MiB;
constexpr size_t WS_LIST = 4 * MiB;
constexpr size_t WS_WBF = 8 * MiB;
constexpr size_t WS_PB = 116 * MiB;
constexpr size_t WS_XN = 132 * MiB;
constexpr size_t WS_MIX = 132 * MiB;
constexpr size_t WS_H2B = 132 * MiB;
constexpr size_t WS_SBQ = 196 * MiB, WS_SBK = 228 * MiB;
constexpr size_t WS_VT = 260 * MiB;
constexpr size_t WS_HQ = 324 * MiB, WS_HK = 356 * MiB, WS_HGATE = 388 * MiB;
constexpr size_t WS_LOGF = 420 * MiB;
constexpr size_t WS_HGD = 484 * MiB;
constexpr size_t WS_SPREV = 196 * MiB;
constexpr size_t WS_H1B = 196 * MiB;
constexpr size_t WS_EST = 196 * MiB;
constexpr size_t WS_XS = 260 * MiB;
constexpr size_t WS_Y = 260 * MiB;
constexpr size_t WS_ACT = 390 * MiB;
constexpr size_t WS_H1Q = 324 * MiB;
constexpr size_t WS_H3B = 260 * MiB;
constexpr size_t WS_RSS = 3 * MiB + 512 * 1024;
constexpr size_t WS_END = 486 * MiB;
constexpr size_t WS_WIN = 8 * MiB, WS_WOUT = 15 * MiB, WS_WPG = 17 * MiB, WS_WPP = 19 * MiB, WS_WRT = 19 * MiB + 512 * 1024, WS_WGU = 20 * MiB, WS_WD = 84 * MiB;
constexpr int CW_CNT = 64, CNT_STRIDE = 64;

struct P {
    const float *x, *p, *attn_w, *w_in, *sb_w, *hg_lb, *hg_w, *w_out, *ffn_w, *wgr, *bgr, *wer, *ber, *weg, *weu, *wed, *ple_w, *wpp, *wpg, *fin_w;
    float* out;
    unsigned char* ws;
    __device__ __forceinline__ unsigned* ctl() const { return (unsigned*)(ws + WS_CTL); }
    __device__ __forceinline__ float* lb() const { return (float*)(ws + WS_LB); }
    __device__ __forceinline__ float* rstd1() const { return (float*)(ws + WS_RSTD1); }
    __device__ __forceinline__ float* rstd2() const { return (float*)(ws + WS_RSTD2); }
    __device__ __forceinline__ float* gate() const { return (float*)(ws + WS_GATE); }
    __device__ __forceinline__ _Float16* hkf() const { return (_Float16*)(ws + WS_LOGF); }
    __device__ __forceinline__ int* toke() const { return (int*)(ws + WS_TOKE); }
    __device__ __forceinline__ int* tokr() const { return (int*)(ws + WS_TOKR); }
    __device__ __forceinline__ int* list() const { return (int*)(ws + WS_LIST); }
    __device__ __forceinline__ bf16* pb() const { return (bf16*)(ws + WS_PB); }
    __device__ __forceinline__ bf16* xn() const { return (bf16*)(ws + WS_XN); }
    __device__ __forceinline__ bf16* mix() const { return (bf16*)(ws + WS_MIX); }
    __device__ __forceinline__ bf16* h2b() const { return (bf16*)(ws + WS_H2B); }
    __device__ __forceinline__ bf16* sbq() const { return (bf16*)(ws + WS_SBQ); }
    __device__ __forceinline__ bf16* sbk() const { return (bf16*)(ws + WS_SBK); }
    __device__ __forceinline__ bf16* vt() const { return (bf16*)(ws + WS_VT); }
    __device__ __forceinline__ bf16* sprev() const { return (bf16*)(ws + WS_SPREV); }
    __device__ __forceinline__ float* hgd() const { return (float*)(ws + WS_HGD); }
    __device__ __forceinline__ bf16* hq() const { return (bf16*)(ws + WS_HQ); }
    __device__ __forceinline__ bf16* hk() const { return (bf16*)(ws + WS_HK); }
    __device__ __forceinline__ bf16* hgate() const { return (bf16*)(ws + WS_HGATE); }
    __device__ __forceinline__ bf16* h1b() const { return (bf16*)(ws + WS_H1B); }
    __device__ __forceinline__ bf16* act() const { return (bf16*)(ws + WS_ACT); }
    __device__ __forceinline__ bf16* y() const { return (bf16*)(ws + WS_Y); }
    __device__ __forceinline__ bf16* est() const { return (bf16*)(ws + WS_EST); }
    __device__ __forceinline__ bf16* win() const { return (bf16*)(ws + WS_WIN); }
    __device__ __forceinline__ bf16* wout() const { return (bf16*)(ws + WS_WOUT); }
    __device__ __forceinline__ bf16* wpg_t() const { return (bf16*)(ws + WS_WPG); }
    __device__ __forceinline__ bf16* wpp_t() const { return (bf16*)(ws + WS_WPP); }
    __device__ __forceinline__ bf16* h3b() const { return (bf16*)(ws + WS_H3B); }
    __device__ __forceinline__ unsigned char* h1q() const { return ws + WS_H1Q; }
    __device__ __forceinline__ unsigned char* wgu8() const { return ws + WS_WGU; }
    __device__ __forceinline__ unsigned char* wd8() const { return ws + WS_WD; }
    __device__ __forceinline__ unsigned char* act8() const { return ws + WS_ACT; }
    __device__ __forceinline__ unsigned char* y8() const { return ws + WS_Y; }
    __device__ __forceinline__ bf16* wrt() const { return (bf16*)(ws + WS_WRT); }
};

constexpr int LDS_BYTES = 147456, MISC_OFF = 131072 + 320, TAB_OFF = 131072 + 1024, GTAB_OFF = 131072 + 2048, GTAB_UNITS = 6, UDESC_OFF = 131072 + 2048 + 12288;

__device__ __forceinline__ void ph_prep_rows(const P& p, int bid, int nb) {
    const int tid = phase_tid(), wave = tid >> 6, lane = tid & 63;
    const int gw = bid * 8 + wave, ngw = nb * 8;
    for (int m = gw; m < M; m += ngw) {
        const float4* xr = (const float4*)(p.x + (size_t)m * DM);
        float4 v[4]; float ss = 0.f;
#pragma unroll
        for (int j = 0; j < 4; ++j) { { typedef float f4_t __attribute__((ext_vector_type(4))); const f4_t t4 = __builtin_nontemporal_load((const f4_t*)xr + lane + 64 * j); v[j] = make_float4(t4[0], t4[1], t4[2], t4[3]); } ss += v[j].x * v[j].x + v[j].y * v[j].y + v[j].z * v[j].z + v[j].w * v[j].w; }
        ss = wave_sum(ss);
        const float r = rsqrtf(ss * (1.0f / DM) + EPS);
        uint2* o = (uint2*)(p.xn() + (size_t)m * DM);
#pragma unroll
        for (int j = 0; j < 4; ++j) {
            const float4 w = ((const float4*)p.attn_w)[lane + 64 * j];
            uint2 t; t.x = pk2(v[j].x * r * w.x, v[j].y * r * w.y); t.y = pk2(v[j].z * r * w.z, v[j].w * r * w.w);
            o[lane + 64 * j] = t;
        }
    }
    const size_t n4 = (size_t)M * PLE / 4;
    for (size_t i = (size_t)bid * NT + tid; i < n4; i += (size_t)nb * NT) {
        typedef float f4_t __attribute__((ext_vector_type(4))); const f4_t t4 = __builtin_nontemporal_load((const f4_t*)p.p + i); const float4 v = make_float4(t4[0], t4[1], t4[2], t4[3]);
        uint2 t; t.x = pk2(v.x, v.y); t.y = pk2(v.z, v.w);
        ((uint2*)p.pb())[i] = t;
    }
    if (bid == 0) {
        for (int c = tid; c < HGW; c += NT) {
            const float a = p.hg_lb[c], b = p.hg_lb[HGW + c], mx = fmaxf(a, b);
            const float ea = expf(a - mx), eb = expf(b - mx);
            p.lb()[c] = ea / (ea + eb);
        }
    }
}

#define LAS __attribute__((address_space(3)))
#define XB_TMO      128
#define XB_XCNT(j)  (256  + 64 * (j))
#define XB_XSUB(j)  (1280 + 64 * (j))
#define XB_XGEN(j)  (2304 + 64 * (j))
#define XB_TOP      3328
#define XB_TOPGEN   3392
#define XCD_BAR_WORDS 3456
#define XB_SPIN_CAP (1u << 18)
__device__ __forceinline__ unsigned xb_ld(unsigned* p)              { return __hip_atomic_load(p, __ATOMIC_RELAXED, __HIP_MEMORY_SCOPE_AGENT); }
__device__ __forceinline__ unsigned xb_add(unsigned* p, unsigned v) { return __hip_atomic_fetch_add(p, v, __ATOMIC_RELAXED, __HIP_MEMORY_SCOPE_AGENT); }
__device__ __forceinline__ unsigned xb_xcc_id() { return (unsigned)__builtin_amdgcn_s_getreg((3 << 11) | 20) & 0xFu; }
#define XB_SPIN(cond, bar) do { unsigned _sp = 0; while (cond) { __builtin_amdgcn_s_sleep(1); \
    if ((++_sp & 255u) == 0u) { if (xb_ld(&(bar)[XB_TMO])) break; if (_sp > XB_SPIN_CAP) { atomicAdd(&(bar)[XB_TMO], 1u); break; } } } } while (0)
struct XcdBarrier { unsigned* bar; unsigned x; volatile LAS unsigned* st; };
__device__ __forceinline__ XcdBarrier xcd_barrier_post(unsigned* bar, volatile LAS unsigned* st) {
    XcdBarrier b; b.bar = bar; b.x = xb_xcc_id(); b.st = st;
    if (threadIdx.x == 0) (void)xb_add(&bar[XB_XCNT(b.x)], 1u);
    return b;
}
__device__ __forceinline__ void xcd_barrier_complete(unsigned* bar, unsigned x, unsigned& nloc, unsigned& nx) {
    const unsigned G = gridDim.x * gridDim.y * gridDim.z;
    unsigned sum, cnt, mine, sp = 0u;
    for (;;) {
        sum = 0u; cnt = 0u; mine = 0u;
#pragma unroll
        for (unsigned j = 0; j < 16; ++j) { const unsigned c = xb_ld(&bar[XB_XCNT(j)]); sum += c; cnt += (c > 0u) ? 1u : 0u; mine = (j == x) ? c : mine; }
        if (sum == G) break;
        __builtin_amdgcn_s_sleep(1);
        if ((++sp & 255u) == 0u) { if (xb_ld(&bar[XB_TMO])) break; if (sp > XB_SPIN_CAP) { atomicAdd(&bar[XB_TMO], 1u); break; } }
    }
    nloc = mine > 0u ? mine : 1u; nx = cnt > 0u ? cnt : 1u;
}
__device__ __forceinline__ void xcd_barrier(const XcdBarrier& b) {
    asm volatile("s_waitcnt vmcnt(0)" ::: "memory");
    __syncthreads();
    if (threadIdx.x == 0) {
        unsigned* bar = b.bar;
        __builtin_amdgcn_s_waitcnt(0);
        unsigned nloc = b.st[0], nx = b.st[1];
        if (nloc == 0u) { xcd_barrier_complete(bar, b.x, nloc, nx); b.st[0] = nloc; b.st[1] = nx; }
        const unsigned old = xb_add(&bar[XB_XSUB(b.x)], 1u);
        const unsigned gen = old / nloc;
        if (old + 1u == (gen + 1u) * nloc) {
            __builtin_amdgcn_fence(__ATOMIC_RELEASE, "agent");
            asm volatile("s_waitcnt vmcnt(0)" ::: "memory");
            const unsigned og = xb_add(&bar[XB_TOP], 1u);
            const unsigned tg = og / nx;
            if (og + 1u == (tg + 1u) * nx) xb_add(&bar[XB_TOPGEN], 1u);
            else XB_SPIN(xb_ld(&bar[XB_TOPGEN]) == tg, bar);
            __builtin_amdgcn_fence(__ATOMIC_ACQUIRE, "agent");
            xb_add(&bar[XB_XGEN(b.x)], 1u);
            asm volatile("s_waitcnt vmcnt(0)" ::: "memory");
        } else {
            XB_SPIN(xb_ld(&bar[XB_XGEN(b.x)]) == gen, bar);
            __builtin_amdgcn_fence(__ATOMIC_ACQUIRE, "agent");
            asm volatile("s_waitcnt vmcnt(0)" ::: "memory");
        }
    }
    __syncthreads();
}


namespace pg8 {
#define PG8_LAS __attribute__((address_space(3)))
typedef short bf16x8 __attribute__((ext_vector_type(8)));
typedef float f32x4 __attribute__((ext_vector_type(4)));
typedef unsigned u32x4 __attribute__((ext_vector_type(4)));
typedef int i32x8 __attribute__((ext_vector_type(8)));
typedef int i32x4 __attribute__((ext_vector_type(4)));
constexpr int BM = 256, BK = 64, HALF = 128, HTB = HALF * BK * 2  , STAGE_BYTES = 8 * HTB, NXCD = 8, WGM = 8;
__host__ __device__ __forceinline__ int lds_byte(int r, int c) { const int st = (r >> 4) * 2 + (c >> 5), rr = r & 15, cc = c & 31, ob = rr * 64 + cc * 2; return st * 1024 + (ob ^ (((ob >> 9) & 1) << 5)); }
__host__ __device__ __forceinline__ void stage_rc(int b, int& R, int& C) { const int st = b / 1024, sb = b % 1024, swz = sb ^ (((sb >> 9) & 1) << 5); R = (st >> 1) * 16 + swz / 64; C = (st & 1) * 32 + (swz % 64) / 2; }
__host__ __device__ __forceinline__ int perm32(int rho) { const int n = rho >> 4, i = rho & 15; return 8 * (i >> 2) + 4 * n + (i & 3); }

struct Unit { const char* A; const char* B; int row0, pn, valid, aux; };

template <bool GATHER = false, bool FP8 = false, class Epi, class Sched>
__device__ __forceinline__ void gemm_phase(PG8_LAS unsigned char* lds, const int K, const Sched& S, const Epi& E, const char* A0 = nullptr, const PG8_LAS int* gtab = nullptr) {
    const int tid = phase_tid(), wid = __builtin_amdgcn_readfirstlane(tid >> 6), lane = tid & 63, wr = wid >> 2, wc = wid & 3, fr = lane & 15, fq = lane >> 4;
    const int nt = K / BK;
    unsigned voffA[2], voffB[2];
#pragma unroll
    for (int i = 0; i < 2; ++i) { int R, C; stage_rc(tid * 16 + i * 8192, R, C); const int Rb = (R & ~31) + perm32(R & 31);
        voffA[i] = (unsigned)(R * K + C) * 2u; voffB[i] = (unsigned)(Rb * K + C) * 2u; }
    const size_t kstep = (size_t)(BK * 2);
    const size_t hstep = (size_t)HALF * K * 2;
    const unsigned ldsw = (unsigned)wid * 1024u;
    const int fcol = fq * 8;
    const int aoff = lds_byte(wr * 64 + fr, fcol), boff = lds_byte(wc * 32 + fr, fcol);
#define PG8_SA(b, h) (((b) * 2 + (h)) * HTB)
#define PG8_SB(b, h) ((4 + (b) * 2 + (h)) * HTB)
#define PG8_STAGE(bufoff, gbase, voff) do { _Pragma("unroll") for (int _i = 0; _i < 2; ++_i) \
        __builtin_amdgcn_global_load_lds((const unsigned*)((const char*)(gbase) + (voff)[_i]), (PG8_LAS unsigned*)(lds + (bufoff) + ldsw + _i * 8192), 16, 0, 0); } while (0)
#define PG8_LDA(dst, b, h) do { if constexpr (FP8) { _Pragma("unroll") for (int m = 0; m < 4; ++m) dst##8[m] = __builtin_shufflevector(*(const PG8_LAS i32x4*)(lds + PG8_SA(b, h) + aoff + m * 2048), *(const PG8_LAS i32x4*)(lds + PG8_SA(b, h) + aoff + m * 2048 + 1024), 0, 1, 2, 3, 4, 5, 6, 7); } \
        else { _Pragma("unroll") for (int m = 0; m < 4; ++m) _Pragma("unroll") for (int k = 0; k < 2; ++k) dst[m][k] = *(const PG8_LAS bf16x8*)(lds + PG8_SA(b, h) + aoff + m * 2048 + k * 1024); } } while (0)
#define PG8_LDB(dst, b, h) do { if constexpr (FP8) { _Pragma("unroll") for (int n = 0; n < 2; ++n) dst##8[n] = __builtin_shufflevector(*(const PG8_LAS i32x4*)(lds + PG8_SB(b, h) + boff + n * 2048), *(const PG8_LAS i32x4*)(lds + PG8_SB(b, h) + boff + n * 2048 + 1024), 0, 1, 2, 3, 4, 5, 6, 7); } \
        else { _Pragma("unroll") for (int n = 0; n < 2; ++n) _Pragma("unroll") for (int k = 0; k < 2; ++k) dst[n][k] = *(const PG8_LAS bf16x8*)(lds + PG8_SB(b, h) + boff + n * 2048 + k * 1024); } } while (0)
#define PG8_MMA(ai, bj, At, Bt) do { __builtin_amdgcn_s_setprio(1); _Pragma("unroll") for (int m = 0; m < 4; ++m) _Pragma("unroll") for (int n = 0; n < 2; ++n) { \
        if constexpr (FP8) asm volatile("v_mfma_f32_16x16x128_f8f6f4 %0, %1, %2, %0" : "+v"(acc[ai][bj][m][n]) : "v"(Bt##8[n]), "v"(At##8[m]));   \
        else { _Pragma("unroll") for (int k = 0; k < 2; ++k) acc[ai][bj][m][n] = __builtin_amdgcn_mfma_f32_16x16x32_bf16(Bt[n][k], At[m][k], acc[ai][bj][m][n], 0, 0, 0); } } \
        __builtin_amdgcn_s_setprio(0); } while (0)
#define PG8_WAIT_V(n) asm volatile("s_waitcnt vmcnt(" #n ")" ::: "memory")
#define PG8_WAIT_L(n) asm volatile("s_waitcnt lgkmcnt(" #n ")" ::: "memory")
#define PG8_BAR __builtin_amdgcn_s_barrier()
#define PG8_SCHED __builtin_amdgcn_sched_barrier(0)
    Unit cur, nxt; int ui = 0;
    if (!S.next(0, cur)) return;
    unsigned goff[2][2] = {{0u, 0u}, {0u, 0u}};
#define PG8_GLOAD(un) do { const PG8_LAS int* t_ = gtab + (un) * 256; \
        _Pragma("unroll") for (int i_ = 0; i_ < 2; ++i_) { int R_, C_; stage_rc(tid * 16 + i_ * 8192, R_, C_); \
            goff[0][i_] = (unsigned)t_[R_] * (unsigned)(2 * K) + (unsigned)(2 * C_); goff[1][i_] = (unsigned)t_[128 + R_] * (unsigned)(2 * K) + (unsigned)(2 * C_); } } while (0)
    if constexpr (GATHER) PG8_GLOAD(0);
#define PG8_STAGE_A(bufoff, kp, h) do { if constexpr (GATHER) PG8_STAGE(bufoff, kp, goff[h]); else PG8_STAGE(bufoff, (kp) + (h) * hstep, voffA); } while (0)
    f32x4 acc[2][2][4][2];
#pragma unroll
    for (int a = 0; a < 2; ++a)
#pragma unroll
        for (int b = 0; b < 2; ++b)
#pragma unroll
            for (int m = 0; m < 4; ++m)
#pragma unroll
                for (int n = 0; n < 2; ++n) acc[a][b][m][n] = (f32x4){0.f, 0.f, 0.f, 0.f};
    bf16x8 At[4][2], B0[2][2], B1[2][2];
    i32x8 At8[4], B08[2], B18[2];
    const char* cA = GATHER ? A0 : cur.A; const char* cB = cur.B;
    PG8_STAGE(PG8_SB(0, 0), cB, voffB); PG8_STAGE(PG8_SB(0, 1), cB + hstep, voffB); PG8_STAGE_A(PG8_SA(0, 0), cA, 0); PG8_STAGE_A(PG8_SA(0, 1), cA, 1);
    if (wr == 1) PG8_BAR;
    PG8_WAIT_V(2); PG8_BAR;
    PG8_STAGE(PG8_SB(1, 0), cB + kstep, voffB); PG8_STAGE_A(PG8_SA(1, 0), cA + kstep, 0); PG8_STAGE(PG8_SB(1, 1), cB + hstep + kstep, voffB);
    PG8_WAIT_V(6); PG8_BAR;
    for (;;) {
        const bool has_next = S.next(ui + 1, nxt);
        const char* nA = GATHER ? A0 : (has_next ? nxt.A : cA); const char* nB = has_next ? nxt.B : cB;
#pragma unroll 1
        for (int t = 0; t < nt; t += 2) {
            const bool last = (t == nt - 2);
            const char* a1 = cA + (size_t)(t + 1) * kstep;
            const char* a2 = last ? nA : cA + (size_t)(t + 2) * kstep; const char* b2 = last ? nB : cB + (size_t)(t + 2) * kstep;
            const char* a3 = a2 + kstep; const char* b3 = b2 + kstep;
            PG8_LDB(B0, 0, 0); PG8_LDB(B1, 0, 1); PG8_SCHED; PG8_LDA(At, 0, 0); PG8_STAGE_A(PG8_SA(1, 1), a1, 1);
            if constexpr (GATHER) { if (last && has_next) PG8_GLOAD(ui + 1); }
            PG8_WAIT_V(8); PG8_WAIT_L(0); PG8_BAR; PG8_MMA(0, 0, At, B0); PG8_MMA(0, 1, At, B1); PG8_BAR; PG8_SCHED;
            PG8_LDA(At, 0, 1); PG8_STAGE(PG8_SB(0, 0), b2, voffB); PG8_STAGE(PG8_SB(0, 1), b2 + hstep, voffB); PG8_STAGE_A(PG8_SA(0, 0), a2, 0);
            PG8_WAIT_V(8); PG8_WAIT_L(0); PG8_BAR; PG8_MMA(1, 0, At, B0); PG8_MMA(1, 1, At, B1); PG8_BAR; PG8_SCHED;
            PG8_LDB(B0, 1, 0); PG8_LDB(B1, 1, 1); PG8_SCHED; PG8_LDA(At, 1, 0); PG8_STAGE_A(PG8_SA(0, 1), a2, 1);
            PG8_WAIT_V(8); PG8_WAIT_L(0); PG8_BAR; PG8_MMA(0, 0, At, B0); PG8_MMA(0, 1, At, B1); PG8_BAR; PG8_SCHED;
            PG8_LDA(At, 1, 1); PG8_STAGE(PG8_SB(1, 0), b3, voffB); PG8_STAGE(PG8_SB(1, 1), b3 + hstep, voffB); PG8_STAGE_A(PG8_SA(1, 0), a3, 0);
            PG8_WAIT_V(8); PG8_WAIT_L(0); PG8_BAR; PG8_MMA(1, 0, At, B0); PG8_MMA(1, 1, At, B1); PG8_BAR; PG8_SCHED;
        }
        if (wr == 0) PG8_BAR;
        if constexpr (FP8) asm volatile("s_nop 15\n\ts_nop 15" ::: "memory");
        E(acc, cur, wr, wc, fr, fq);
        if (!has_next) break;
#pragma unroll
        for (int a = 0; a < 2; ++a)
#pragma unroll
            for (int b = 0; b < 2; ++b)
#pragma unroll
                for (int m = 0; m < 4; ++m)
#pragma unroll
                    for (int n = 0; n < 2; ++n) acc[a][b][m][n] = (f32x4){0.f, 0.f, 0.f, 0.f};
        cur = nxt; cA = nA; cB = nB; ++ui;
        if (wr == 1) PG8_BAR;
    }
    PG8_WAIT_V(0);
    PG8_BAR;
#undef PG8_SA
#undef PG8_SB
#undef PG8_STAGE
#undef PG8_STAGE_A
#undef PG8_GLOAD
#undef PG8_LDA
#undef PG8_LDB
#undef PG8_MMA
#undef PG8_WAIT_V
#undef PG8_WAIT_L
#undef PG8_BAR
#undef PG8_SCHED
}

struct DenseOrder {
    const char* A; const char* B; int nM, nN, nwg, G, c; size_t tstep;
    __device__ void init(const void* A_, const void* B_, int M_, int N_, int K_, int G_, int c_) { A = (const char*)A_; B = (const char*)B_; nM = M_ / BM; nN = N_ / BM; nwg = nM * nN; G = G_; c = c_; tstep = (size_t)BM * K_ * 2; }
    __device__ bool next(int i, Unit& u) const {
        const long L = (long)i * G + c; if (L >= nwg) return false;
        int wgid = (int)L; { const int q = nwg / NXCD, r = nwg % NXCD, xcd = wgid % NXCD, off = wgid / NXCD; wgid = (xcd < r ? xcd * (q + 1) : r * (q + 1) + (xcd - r) * q) + off; }
        const int nig = WGM * nN, gid = wgid / nig, fm = gid * WGM, gsz = (nM - fm) < WGM ? (nM - fm) : WGM;
        const int pm = fm + ((wgid % nig) % gsz), pn = (wgid % nig) / gsz;
        u.A = A + (size_t)pm * tstep; u.B = B + (size_t)pn * tstep; u.row0 = pm * BM; u.pn = pn; u.valid = BM; u.aux = 0; return true;
    }
};
}

typedef float f32x4 __attribute__((ext_vector_type(4)));
typedef unsigned u32x4 __attribute__((ext_vector_type(4)));
typedef unsigned u32x2 __attribute__((ext_vector_type(2)));
typedef float f32x2 __attribute__((ext_vector_type(2)));
constexpr float QSCALE = 0.125f * 1.4426950408889634f;
__device__ __forceinline__ float fsigmoid(float x) { return __builtin_amdgcn_rcpf(1.0f + __builtin_amdgcn_exp2f(-1.4426950408889634f * x)); }

struct MoeTab { int cnt[NE], off[NE + 1], tpre[NE + 1]; unsigned char tile_e[320]; };
__device__ __forceinline__ void moe_tab(const P& p, MoeTab* T) {
    __syncthreads();
    if (threadIdx.x < 64) {
        const int lane = threadIdx.x;
        const int c = lane < NE ? (int)__hip_atomic_load(&p.ctl()[CW_CNT + lane * CNT_STRIDE], __ATOMIC_RELAXED, __HIP_MEMORY_SCOPE_AGENT) : 0;
        const int nt_ = (c + 255) / 256;
        int so = c, st = nt_;
#pragma unroll
        for (int d = 1; d < 32; d <<= 1) { const int a_ = __shfl_up(so, d), b_ = __shfl_up(st, d); if (lane >= d) { so += a_; st += b_; } }
        if (lane < NE) {
            T->cnt[lane] = c; T->off[lane] = so - c; T->tpre[lane] = st - nt_;
            for (int j = 0; j < nt_; ++j) T->tile_e[st - nt_ + j] = (unsigned char)lane;
        }
        if (lane == NE - 1) { T->off[NE] = so; T->tpre[NE] = st; }
    }
    __syncthreads();
}
__device__ __forceinline__ bool moe_unit(const MoeTab* T, int i, int c, int G, int& mt, int& pn) {
    if ((G & 31) == 0) { const int per = G >> 3, mpg = per >> 2, x = c & 7, j = c >> 3; mt = (i * 8 + x) * mpg + (j >> 2); pn = j & 3; }
    else { const int L = i * G + c; mt = L >> 2; pn = L & 3; }
    return mt < T->tpre[NE];
}
struct MoeOrder {
    const LAS int* ud; const char* A; const char* B; size_t a_pitch, b_exp; size_t b_tile;
    __device__ bool next(int i, pg8::Unit& u) const {
        if (i >= GTAB_UNITS) return false;
        const int row0 = ud[4 * i], valid = ud[4 * i + 1], e = ud[4 * i + 2], pn = ud[4 * i + 3];
        if (valid == 0) return false;
        u.row0 = row0; u.valid = valid; u.pn = pn; u.aux = i;
        u.A = A + (size_t)row0 * a_pitch; u.B = B + (size_t)e * b_exp + (size_t)pn * b_tile; return true;
    }
};

#define EPI_FR int frl_ = fr; asm volatile("" : "+v"(frl_));
#define EPI_ROWS_BEGIN _Pragma("unroll") for (int ai = 0; ai < 2; ++ai) _Pragma("unroll") for (int m = 0; m < 4; ++m) { const int rt = ai * 128 + wr * 64 + m * 16 + frl_;
#define EPI_ROWS_END }
__device__ __forceinline__ u32x4 pack8(const f32x4 a, const f32x4 b) { u32x4 w; w.x = pk2(a[0], a[1]); w.y = pk2(a[2], a[3]); w.z = pk2(b[0], b[1]); w.w = pk2(b[2], b[3]); return w; }

struct EpiInProj {
    P p;
    template <int SEG>
    __device__ __forceinline__ void rows(const f32x4 (&acc)[2][2][4][2], const pg8::Unit& u, int wr, int frl_, int cb, bf16* dst) const {
#pragma unroll
        for (int bj = 0; bj < 2; ++bj) {
            const int c = cb + bj * 128;
            f32x4 l0 = {0.f, 0.f, 0.f, 0.f}, l1 = l0;
            if (SEG == 3) { l0 = *(const f32x4*)(p.lb() + c); l1 = *(const f32x4*)(p.lb() + c + 4); asm volatile("" : "+v"(l0), "+v"(l1)); }
            EPI_ROWS_BEGIN
                const size_t o = (size_t)(u.row0 + rt) * 512 + c;
                f32x4 v0 = acc[ai][bj][m][0], v1 = acc[ai][bj][m][1];
                if (SEG == 0) { v0 = v0 * QSCALE; v1 = v1 * QSCALE; }
                else if (SEG == 2 || SEG == 4) {
#pragma unroll
                    for (int q = 0; q < 4; ++q) { v0[q] = v0[q] * fsigmoid(v0[q]); v1[q] = v1[q] * fsigmoid(v1[q]); }
                } else if (SEG == 3) {
#pragma unroll
                    for (int q = 0; q < 4; ++q) { v0[q] = (1.0f - l0[q]) * fsigmoid(-v0[q]); v1[q] = (1.0f - l1[q]) * fsigmoid(-v1[q]); }
                    typedef _Float16 f16x8 __attribute__((ext_vector_type(8)));
                    *(f16x8*)(p.hkf() + o) = (f16x8){(_Float16)v0[0], (_Float16)v0[1], (_Float16)v0[2], (_Float16)v0[3], (_Float16)v1[0], (_Float16)v1[1], (_Float16)v1[2], (_Float16)v1[3]};
                }
                if (SEG != 3) *(u32x4*)(dst + o) = pack8(v0, v1);
            EPI_ROWS_END
        }
    }
    __device__ __forceinline__ void operator()(const f32x4 (&acc)[2][2][4][2], const pg8::Unit& u, int wr, int wc, int fr, int fq) const {
        EPI_FR
        const int colt = u.pn * 256, seg = colt >> 9, cb = (colt & 511) + wc * 32 + 8 * fq;
        if (seg == 0) rows<0>(acc, u, wr, frl_, cb, p.sbq());
        else if (seg == 1) rows<1>(acc, u, wr, frl_, cb, p.sbk());
        else if (seg == 2) rows<2>(acc, u, wr, frl_, cb, p.hq());
        else if (seg == 3) rows<3>(acc, u, wr, frl_, cb, nullptr);
        else rows<4>(acc, u, wr, frl_, cb, p.hgate());
    }
};
struct EpiVT {
    P p;
    __device__ __forceinline__ void operator()(const f32x4 (&acc)[2][2][4][2], const pg8::Unit& u, int wr, int wc, int fr, int fq) const {
        EPI_FR
#pragma unroll
        for (int bj = 0; bj < 2; ++bj) {
            const int c = u.pn * 256 + bj * 128 + wc * 32 + 8 * fq;
            EPI_ROWS_BEGIN *(u32x4*)(p.vt() + (size_t)(u.row0 + rt) * M + c) = pack8(acc[ai][bj][m][0], acc[ai][bj][m][1]); EPI_ROWS_END
        }
    }
};
struct EpiOutProj {
    P p;
    __device__ __forceinline__ void operator()(const f32x4 (&acc)[2][2][4][2], const pg8::Unit& u, int wr, int wc, int fr, int fq) const {
        EPI_FR
        const int cb = u.pn * 256 + wc * 32 + 8 * fq;
        f32x4 xa[2][4], xb[2][4];
#define OP_LD(b, s) _Pragma("unroll") for (int m = 0; m < 4; ++m) { const size_t o = (size_t)(u.row0 + ((b) & 1) * 128 + wr * 64 + m * 16 + frl_) * DM + cb + ((b) >> 1) * 128; \
            xa[s][m] = *(const f32x4*)(p.x + o); xb[s][m] = *(const f32x4*)(p.x + o + 4); }
#define OP_CS(b, s) _Pragma("unroll") for (int m = 0; m < 4; ++m) { const size_t o = (size_t)(u.row0 + ((b) & 1) * 128 + wr * 64 + m * 16 + frl_) * DM + cb + ((b) >> 1) * 128; \
            const f32x4 h0 = xa[s][m] + acc[(b) & 1][(b) >> 1][m][0], h1 = xb[s][m] + acc[(b) & 1][(b) >> 1][m][1]; \
            *(u32x4*)(p.h1b() + o) = pack8(h0, h1); \
            const f32x4 q0 = h0 * FP8_SH, q1 = h1 * FP8_SH; \
            *(u32x2*)(p.h1q() + o) = (u32x2){pk4_fp8(q0[0], q0[1], q0[2], q0[3]), pk4_fp8(q1[0], q1[1], q1[2], q1[3])}; }
        OP_LD(0, 0) OP_LD(1, 1) OP_CS(0, 0) OP_LD(2, 0) OP_CS(1, 1) OP_LD(3, 1) OP_CS(2, 0) OP_CS(3, 1)
#undef OP_LD
#undef OP_CS
    }
};
struct EpiMoeUp {
    P p; const LAS float* rtab;
    __device__ __forceinline__ void operator()(const f32x4 (&acc)[2][2][4][2], const pg8::Unit& u, int wr, int wc, int fr, int fq) const {
        EPI_FR
        const int c = u.pn * 128 + wc * 32 + 8 * fq;
        EPI_ROWS_BEGIN
            if (rt < u.valid) {
                const float rs = rtab[u.aux * 256 + rt] * (1.0f / (FP8_SH * FP8_SW1));
                f32x4 a0, a1;
#pragma unroll
                for (int q = 0; q < 4; ++q) {
                    const float g0 = acc[ai][0][m][0][q] * rs, g1 = acc[ai][0][m][1][q] * rs;
                    a0[q] = g0 * fsigmoid(g0) * (acc[ai][1][m][0][q] * rs) * FP8_SA; a1[q] = g1 * fsigmoid(g1) * (acc[ai][1][m][1][q] * rs) * FP8_SA;
                }
                *(u32x2*)(p.act8() + (size_t)(u.row0 + rt) * DE + c) = (u32x2){pk4_fp8(a0[0], a0[1], a0[2], a0[3]), pk4_fp8(a1[0], a1[1], a1[2], a1[3])};
            }
        EPI_ROWS_END
    }
};
struct EpiMoeDown {
    P p;
    __device__ __forceinline__ void operator()(const f32x4 (&acc)[2][2][4][2], const pg8::Unit& u, int wr, int wc, int fr, int fq) const {
        EPI_FR
        constexpr float sc = FP8_SY / (FP8_SA * FP8_SW2);
#pragma unroll
        for (int bj = 0; bj < 2; ++bj) {
            const int c = u.pn * 256 + bj * 128 + wc * 32 + 8 * fq;
            EPI_ROWS_BEGIN
                if (rt < u.valid) { const f32x4 a = acc[ai][bj][m][0] * sc, b = acc[ai][bj][m][1] * sc;
                    *(u32x2*)(p.y8() + (size_t)(u.row0 + rt) * DM + c) = (u32x2){pk4_fp8(a[0], a[1], a[2], a[3]), pk4_fp8(b[0], b[1], b[2], b[3])}; }
            EPI_ROWS_END
        }
    }
};
struct EpiPleE {
    P p;
    __device__ __forceinline__ void operator()(const f32x4 (&acc)[2][2][4][2], const pg8::Unit& u, int wr, int wc, int fr, int fq) const {
        EPI_FR
#pragma unroll
        for (int bj = 0; bj < 2; ++bj) {
            const int c = u.pn * 256 + bj * 128 + wc * 32 + 8 * fq;
            EPI_ROWS_BEGIN *(u32x4*)(p.est() + (size_t)(u.row0 + rt) * DM + c) = pack8(acc[ai][bj][m][0], acc[ai][bj][m][1]); EPI_ROWS_END
        }
    }
};
struct EpiPleGate {
    P p;
    __device__ __forceinline__ void operator()(const f32x4 (&acc)[2][2][4][2], const pg8::Unit& u, int wr, int wc, int fr, int fq) const {
        EPI_FR
        const int cb = u.pn * 256 + wc * 32 + 8 * fq;
        u32x4 ev[2][4], hv[2][4]; float rv[2][4];
#define PG_LD(b, s) _Pragma("unroll") for (int m = 0; m < 4; ++m) { const int row = u.row0 + ((b) & 1) * 128 + wr * 64 + m * 16 + frl_; const size_t o = (size_t)row * DM + cb + ((b) >> 1) * 128; \
            rv[s][m] = p.rstd2()[row]; ev[s][m] = *(const u32x4*)(p.est() + o); hv[s][m] = *(const u32x4*)(p.h2b() + o); }
#define PG_CS(b, s) _Pragma("unroll") for (int m = 0; m < 4; ++m) { const size_t o = (size_t)(u.row0 + ((b) & 1) * 128 + wr * 64 + m * 16 + frl_) * DM + cb + ((b) >> 1) * 128; \
            const float rs = rv[s][m]; const u32x4 e = ev[s][m], hb = hv[s][m]; \
            const f32x4 g0 = acc[(b) & 1][(b) >> 1][m][0], g1 = acc[(b) & 1][(b) >> 1][m][1]; \
            f32x4 h0, h1; \
            h0[0] = bflo(hb.x) + fsigmoid(g0[0] * rs) * bflo(e.x); h0[1] = bfhi(hb.x) + fsigmoid(g0[1] * rs) * bfhi(e.x); h0[2] = bflo(hb.y) + fsigmoid(g0[2] * rs) * bflo(e.y); h0[3] = bfhi(hb.y) + fsigmoid(g0[3] * rs) * bfhi(e.y); \
            h1[0] = bflo(hb.z) + fsigmoid(g1[0] * rs) * bflo(e.z); h1[1] = bfhi(hb.z) + fsigmoid(g1[1] * rs) * bfhi(e.z); h1[2] = bflo(hb.w) + fsigmoid(g1[2] * rs) * bflo(e.w); h1[3] = bfhi(hb.w) + fsigmoid(g1[3] * rs) * bfhi(e.w); \
            *(u32x4*)(p.h3b() + o) = pack8(h0, h1); }
        PG_LD(0, 0) PG_CS(0, 0) PG_LD(1, 1) PG_LD(2, 0) PG_CS(1, 1) PG_LD(3, 1) PG_CS(2, 0) PG_CS(3, 1)
#undef PG_LD
#undef PG_CS
    }
};

struct TItem { const float* W; bf16* WT; unsigned char* WT8; const float* ks; const float* dummy; float wscale; int K, N, rowmode, k0, n0; };
__device__ __forceinline__ TItem t_decode(const P& p, int it) {
    constexpr int I_IN = 16 * (INC / 64), I_SQ = 16 * 16, I_PP = 4 * 16, I_G = 16 * 8, I_D = 8 * 16;
    TItem t; int r = it; t.WT8 = nullptr; t.wscale = 1.f; t.dummy = p.attn_w;
    if (r < I_IN) { t.W = p.w_in; t.WT = p.win(); t.ks = nullptr; t.K = DM; t.N = INC; t.rowmode = 3; }
    else if ((r -= I_IN) < I_SQ) { t.W = p.w_out; t.WT = p.wout(); t.ks = nullptr; t.K = DM; t.N = DM; t.rowmode = 0; }
    else if ((r -= I_SQ) < I_SQ) { t.W = p.wpg; t.WT = p.wpg_t(); t.ks = p.ple_w; t.K = DM; t.N = DM; t.rowmode = 0; }
    else if ((r -= I_SQ) < I_PP) { t.W = p.wpp; t.WT = p.wpp_t(); t.ks = nullptr; t.K = PLE; t.N = DM; t.rowmode = 0; }
    else {
        r -= I_PP; const int e = r / (2 * I_G + I_D); r -= e * (2 * I_G + I_D);
        if (r < I_G) { t.W = p.weg + (size_t)e * DM * DE; t.WT = nullptr; t.WT8 = p.wgu8() + (size_t)e * DM * DM; t.wscale = FP8_SW1; t.ks = p.ffn_w; t.K = DM; t.N = DE; t.rowmode = 1; }
        else if ((r -= I_G) < I_G) { t.W = p.weu + (size_t)e * DM * DE; t.WT = nullptr; t.WT8 = p.wgu8() + (size_t)e * DM * DM; t.wscale = FP8_SW1; t.ks = p.ffn_w; t.K = DM; t.N = DE; t.rowmode = 2; }
        else { r -= I_G; t.W = p.wed + (size_t)e * DE * DM; t.WT = nullptr; t.WT8 = p.wd8() + (size_t)e * DM * DE; t.wscale = FP8_SW2; t.ks = nullptr; t.K = DE; t.N = DM; t.rowmode = 0; }
    }
    const int nblk = t.N / 64; t.k0 = 64 * (r / nblk); t.n0 = 64 * (r % nblk);
    return t;
}
__device__ __forceinline__ void t_load(const TItem& t, f32x4 (&v)[16], f32x4 (&sc)[2], int lane) {
    const int lr = lane >> 4, c4 = lane & 15;
#pragma unroll
    for (int i = 0; i < 16; ++i) v[i] = *(const f32x4*)(t.W + (size_t)(t.k0 + 4 * i + lr) * t.N + t.n0 + c4 * 4);
    const float* ksp = (t.ks ? t.ks : t.dummy) + t.k0 + 8 * (lane & 7); const float use = t.ks ? 1.f : 0.f, one = 1.f - use;
    sc[0] = *(const f32x4*)(ksp) * use + one; sc[1] = *(const f32x4*)(ksp + 4) * use + one;
}
__device__ __forceinline__ void t_store(const TItem& t, f32x4 (&v)[16], const f32x4 (&sc)[2], LAS float* scr, int lane) {
    const int lr = lane >> 4, c4 = lane & 15;
#pragma unroll
    for (int i = 0; i < 16; ++i) {
        const int kk = 4 * i + lr;
        *(LAS f32x4*)(scr + kk * 64 + ((c4 ^ ((kk >> 3) & 7)) << 2)) = v[i];
    }
    asm volatile("s_waitcnt lgkmcnt(0)" ::: "memory");
    const int n0 = t.n0, seg3 = n0 >> 9, dseg3 = seg3 < 2 ? seg3 : seg3 == 2 ? 5 : seg3 == 3 ? 2 : seg3 == 4 ? 3 : seg3 == 5 ? 6 : 4;
    const int rbase = t.rowmode == 0 ? n0 : t.rowmode == 3 ? dseg3 * 512 + (n0 & 511) : (n0 >> 7) * 256 + (n0 & 127) + (t.rowmode == 2 ? 128 : 0);
    const int c = lane & 7;
#pragma unroll
    for (int j = 0; j < 8; ++j) {
        const int n = (lane >> 3) + 8 * j;
        const LAS float* s = scr + (8 * c) * 64 + ((((n >> 2) ^ c) << 2) | (n & 3));
        u32x4 o; o.x = pk2(s[0] * sc[0][0], s[64] * sc[0][1]); o.y = pk2(s[128] * sc[0][2], s[192] * sc[0][3]); o.z = pk2(s[256] * sc[1][0], s[320] * sc[1][1]); o.w = pk2(s[384] * sc[1][2], s[448] * sc[1][3]);
        *(u32x4*)(t.WT + (size_t)(rbase + n) * t.K + t.k0 + 8 * c) = o;
    }
    asm volatile("s_waitcnt lgkmcnt(0)" ::: "memory");
}
__device__ __forceinline__ void t_load8(const TItem& t, f32x4 (&v)[16], f32x4 (&sc)[4], int lane) {
    const int lr = lane >> 4, c4 = lane & 15;
#pragma unroll
    for (int i = 0; i < 16; ++i) v[i] = *(const f32x4*)(t.W + (size_t)(t.k0 + 4 * i + lr) * t.N + t.n0 + c4 * 4);
#pragma unroll
    for (int q = 0; q < 4; ++q) sc[q] = *(const f32x4*)((t.ks ? t.ks : t.dummy) + t.k0 + 16 * (lane & 3) + 4 * q);
}
__device__ __forceinline__ void t_store8(const TItem& t, f32x4 (&v)[16], const f32x4 (&sc)[4], LAS float* scr, int lane) {
    const int lr = lane >> 4, c4 = lane & 15;
#pragma unroll
    for (int i = 0; i < 16; ++i) {
        const int kk = 4 * i + lr;
        *(LAS f32x4*)(scr + kk * 64 + ((c4 ^ ((kk >> 3) & 7)) << 2)) = v[i];
    }
    asm volatile("s_waitcnt lgkmcnt(0)" ::: "memory");
    const int n0 = t.n0;
    const int rbase = t.rowmode == 0 ? n0 : (n0 >> 7) * 256 + (n0 & 127) + (t.rowmode == 2 ? 128 : 0);
    const float ksu = t.ks ? t.wscale : 0.f, ksc = t.ks ? 0.f : t.wscale;
    const int c = lane & 3;
#pragma unroll
    for (int j = 0; j < 4; ++j) {
        const int n = (lane >> 2) + 16 * j;
        float w[16];
#pragma unroll
        for (int q = 0; q < 16; ++q) { const int sw = (2 * c + (q >> 3)) & 7; w[q] = scr[(16 * c + q) * 64 + ((((n >> 2) ^ sw) << 2) | (n & 3))] * (sc[q >> 2][q & 3] * ksu + ksc); }
        const u32x4 o = {pk4_fp8(w[0], w[1], w[2], w[3]), pk4_fp8(w[4], w[5], w[6], w[7]), pk4_fp8(w[8], w[9], w[10], w[11]), pk4_fp8(w[12], w[13], w[14], w[15])};
        *(u32x4*)(t.WT8 + (size_t)(rbase + n) * t.K + t.k0 + 16 * c) = o;
    }
    asm volatile("s_waitcnt lgkmcnt(0)" ::: "memory");
}
constexpr int T_NITEMS = 16 * (INC / 64) + 2 * 256 + 64 + NE * (2 * 128 + 128), T_DENSE_ITEMS = 16 * (INC / 64) + 2 * 256 + 64;
template <bool F8>
__device__ __forceinline__ void ph_prep_weights(const P& p, LAS unsigned char* lds, int bid, int nb, int lo, int hi, int w0, int nw) {
    const int tid = phase_tid(), wave = __builtin_amdgcn_readfirstlane(tid >> 6), lane = tid & 63;
    if (wave < w0 || wave >= w0 + nw) return;
    LAS float* scr = (LAS float*)(lds + wave * 16384);
    const int gw = bid * nw + (wave - w0), ngw = nb * nw;
    f32x4 va[16], vb[16], sa[4], sb[4];
    int it = lo + gw;
    if (it >= hi) return;
    TItem ta = t_decode(p, it), tb = ta;
#define T_LOAD(t, v, s) do { if constexpr (F8) t_load8(t, v, s, lane); else t_load(t, v, (f32x4(&)[2])s, lane); } while (0)
#define T_STORE(t, v, s) do { if constexpr (F8) t_store8(t, v, s, scr, lane); else t_store(t, v, (const f32x4(&)[2])s, scr, lane); } while (0)
    T_LOAD(ta, va, sa);
    __builtin_amdgcn_sched_barrier(0);
    for (; it < hi; it += 2 * ngw) {
        const int i1 = it + ngw, i2 = it + 2 * ngw;
        tb = t_decode(p, i1 < hi ? i1 : it); T_LOAD(tb, vb, sb);
        __builtin_amdgcn_sched_barrier(0);
        T_STORE(ta, va, sa);
        ta = t_decode(p, i2 < hi ? i2 : it); T_LOAD(ta, va, sa);
        __builtin_amdgcn_sched_barrier(0);
        if (i1 < hi) T_STORE(tb, vb, sb);
    }
#undef T_LOAD
#undef T_STORE
}

__device__ __forceinline__ void ph_prep_router(const P& p, int bid, int nb) {
    for (int i = bid * NT + threadIdx.x; i < 96 * DM; i += nb * NT) {
        const int row = i >> 10, k = i & 1023, tau = row >> 5, rho = row & 31;
        float v = 0.f;
        if ((rho & 4) == 0) {
            const int r = (rho & 3) + 4 * (rho >> 3), L = tau * 16 + r;
            if (L < 4) v = p.ffn_w[k] * p.wgr[k * 4 + L]; else if (L < 36) v = p.ffn_w[k] * p.wer[k * 32 + L - 4];
        }
        p.wrt()[i] = f2bf(v);
    }
}

__device__ __forceinline__ void moe_fill_tables(const P& p, const MoeTab* T, LAS unsigned char* lds, int bid, int nb) {
    LAS int* gtab = (LAS int*)(lds + GTAB_OFF); LAS float* rtab = (LAS float*)(lds + GTAB_OFF + GTAB_UNITS * 1024); LAS int* ud = (LAS int*)(lds + UDESC_OFF);
    const int tid = phase_tid();
    int ue[GTAB_UNITS], ur0[GTAB_UNITS], ucnt[GTAB_UNITS], tok[GTAB_UNITS]; bool uok[GTAB_UNITS];
#pragma unroll
    for (int i = 0; i < GTAB_UNITS; ++i) {
        int mt, pn;
        uok[i] = moe_unit(T, i, bid, nb, mt, pn);
        const int e = uok[i] ? (int)T->tile_e[mt] : 0;
        ue[i] = e; ur0[i] = uok[i] ? (mt - T->tpre[e]) * 256 : 0; ucnt[i] = uok[i] ? T->cnt[e] : 1;
        if (tid == 0) { const int rem = ucnt[i] - ur0[i]; ud[4 * i] = T->off[e] + ur0[i]; ud[4 * i + 1] = uok[i] ? (rem < 256 ? rem : 256) : 0; ud[4 * i + 2] = e; ud[4 * i + 3] = pn; }
    }
    if (tid < 256) {
#pragma unroll
        for (int i = 0; i < GTAB_UNITS; ++i) {
            int rk = ur0[i] + tid; if (rk >= ucnt[i]) rk = ucnt[i] - 1;
            tok[i] = uok[i] ? p.list()[ue[i] * M + rk] : 0;
        }
        float rsv[GTAB_UNITS];
#pragma unroll
        for (int i = 0; i < GTAB_UNITS; ++i) rsv[i] = p.rstd1()[tok[i]];
#pragma unroll
        for (int i = 0; i < GTAB_UNITS; ++i) if (uok[i]) { gtab[i * 256 + tid] = tok[i]; rtab[i * 256 + tid] = rsv[i]; }
    }
    __syncthreads();
}

typedef short bf16x8 __attribute__((ext_vector_type(8)));
typedef float f32x16 __attribute__((ext_vector_type(16)));
constexpr int SB_STG_PITCH = 68, SB_STG_BYTES = 32 * SB_STG_PITCH * 4;
__device__ __forceinline__ float partner32(float x, int hi) {
    const unsigned xb = __float_as_uint(x);
    const auto rr = __builtin_amdgcn_permlane32_swap(xb, xb, false, false);
    (void)hi;
    return __uint_as_float(rr[0] != xb ? rr[0] : rr[1]);
}
#define SB_WAIT_V(n) asm volatile("s_waitcnt vmcnt(" #n ")" ::: "memory")
__device__ __forceinline__ void sb_dma_tile(const bf16* g, size_t row_pitch, LAS unsigned char* l, int lane) {
    const int p = lane & 7;
#pragma unroll
    for (int i = 0; i < 8; ++i) {
        const int row = 8 * i + (lane >> 3), c = p ^ ((row >> 1) & 7);
        __builtin_amdgcn_global_load_lds((const unsigned*)(g + (size_t)row * row_pitch + c * 8), (LAS unsigned*)(l + i * 1024), 16, 0, 0);
    }
}
__device__ __forceinline__ void sb_unit(const P& p, LAS unsigned char* wl, int b, int h, int qblk, int lane) {
    const int r32 = lane & 31, hi = lane >> 5, q0 = qblk * 32, swr = (r32 >> 1) & 7;
    const size_t tok0 = (size_t)b * SEQ;
    const bf16* Kg = p.sbk() + tok0 * 512 + h * 64;
    const bf16* Vg = p.vt() + (size_t)(h * 64) * M + tok0;
    LAS unsigned char* kl = wl; LAS unsigned char* vl = wl + 8192;
    const int jdiag = (q0 + 31) >> 6;
    sb_dma_tile(Kg + (size_t)jdiag * 64 * 512, 512, kl, lane);
    sb_dma_tile(Vg + jdiag * 64, M, vl, lane);
    bf16x8 qf[4];
    {
        const bf16* Qp = p.sbq() + (tok0 + q0 + r32) * 512 + h * 64 + hi * 8;
#pragma unroll
        for (int d0 = 0; d0 < 4; ++d0) qf[d0] = *(const bf16x8*)(Qp + d0 * 16);
    }
    f32x16 o0, o1;
#pragma unroll
    for (int r = 0; r < 16; ++r) { o0[r] = 0.f; o1[r] = 0.f; }
    float C = 1.0f;
    const int t = q0 + r32;
    const LAS unsigned char* kr = kl + r32 * 128; const LAS unsigned char* vr = vl + r32 * 128 + hi * 8;
    for (int jt = jdiag; jt >= 0; --jt) {
        const int kv0 = jt * 64, jn = jt > 0 ? jt - 1 : 0;
        SB_WAIT_V(8);
        bf16x8 kf[8];
#pragma unroll
        for (int d0 = 0; d0 < 4; ++d0) {
            kf[2 * d0] = *(const LAS bf16x8*)(kr + (((2 * d0 + hi) ^ swr) << 4));
            kf[2 * d0 + 1] = *(const LAS bf16x8*)(kr + 32 * 128 + (((2 * d0 + hi) ^ swr) << 4));
        }
        f32x16 p0, p1;
#pragma unroll
        for (int r = 0; r < 16; ++r) { p0[r] = 0.f; p1[r] = 0.f; }
#pragma unroll
        for (int d0 = 0; d0 < 4; ++d0) {
            p0 = __builtin_amdgcn_mfma_f32_32x32x16_bf16(kf[2 * d0], qf[d0], p0, 0, 0, 0);
            p1 = __builtin_amdgcn_mfma_f32_32x32x16_bf16(kf[2 * d0 + 1], qf[d0], p1, 0, 0, 0);
        }
        asm volatile("s_waitcnt lgkmcnt(0)" ::: "memory");
        sb_dma_tile(Kg + (size_t)jn * 64 * 512, 512, kl, lane);
        f32x16 b0, b1;
#pragma unroll
        for (int r = 0; r < 16; ++r) {
            const float e0 = __builtin_amdgcn_exp2f(p0[r]), e1 = __builtin_amdgcn_exp2f(p1[r]);
            const float r0 = __builtin_amdgcn_rcpf(1.0f + e0), r1 = __builtin_amdgcn_rcpf(1.0f + e1);
            p0[r] = r0; p1[r] = r1; b0[r] = 1.0f - r0; b1[r] = 1.0f - r1;
        }
        if (jt == jdiag) {
#pragma unroll
            for (int r = 0; r < 16; ++r) {
                const int kv = kv0 + (r & 3) + 8 * (r >> 2) + 4 * hi;
                if (kv >= t) { p0[r] = 1.0f; b0[r] = 0.f; }
                if (kv + 32 >= t) { p1[r] = 1.0f; b1[r] = 0.f; }
            }
        }
        float T[8], X[8];
#pragma unroll
        for (int i = 0; i < 4; ++i) { T[i] = (p0[4 * i] * p0[4 * i + 1]) * (p0[4 * i + 2] * p0[4 * i + 3]); T[4 + i] = (p1[4 * i] * p1[4 * i + 1]) * (p1[4 * i + 2] * p1[4 * i + 3]); }
        float suf = 1.0f;
#pragma unroll
        for (int i = 7; i >= 0; --i) {
            const float part = partner32(T[i], hi);
            X[i] = (hi ? suf : suf * part) * C;
            suf *= T[i] * part;
        }
        C *= suf;
#pragma unroll
        for (int i = 0; i < 4; ++i) {
            float w = X[i];
            b0[4 * i + 3] *= w; w *= p0[4 * i + 3]; b0[4 * i + 2] *= w; w *= p0[4 * i + 2]; b0[4 * i + 1] *= w; w *= p0[4 * i + 1]; b0[4 * i] *= w;
            w = X[4 + i];
            b1[4 * i + 3] *= w; w *= p1[4 * i + 3]; b1[4 * i + 2] *= w; w *= p1[4 * i + 2]; b1[4 * i + 1] *= w; w *= p1[4 * i + 1]; b1[4 * i] *= w;
        }
        u32x4 pa[4];
#pragma unroll
        for (int s = 0; s < 2; ++s) {
            pa[s] = (u32x4){pk2(b0[8 * s], b0[8 * s + 1]), pk2(b0[8 * s + 2], b0[8 * s + 3]), pk2(b0[8 * s + 4], b0[8 * s + 5]), pk2(b0[8 * s + 6], b0[8 * s + 7])};
            pa[2 + s] = (u32x4){pk2(b1[8 * s], b1[8 * s + 1]), pk2(b1[8 * s + 2], b1[8 * s + 3]), pk2(b1[8 * s + 4], b1[8 * s + 5]), pk2(b1[8 * s + 6], b1[8 * s + 7])};
        }
        SB_WAIT_V(8);
#pragma unroll
        for (int s = 0; s < 4; ++s) {
            const u32x2 l0 = *(const LAS u32x2*)(vr + (((2 * s) ^ swr) << 4)), h0 = *(const LAS u32x2*)(vr + (((2 * s + 1) ^ swr) << 4));
            const u32x2 l1 = *(const LAS u32x2*)(vr + 32 * 128 + (((2 * s) ^ swr) << 4)), h1 = *(const LAS u32x2*)(vr + 32 * 128 + (((2 * s + 1) ^ swr) << 4));
            const u32x4 v0 = {l0.x, l0.y, h0.x, h0.y}, v1 = {l1.x, l1.y, h1.x, h1.y};
            o0 = __builtin_amdgcn_mfma_f32_32x32x16_bf16(__builtin_bit_cast(bf16x8, pa[s]), __builtin_bit_cast(bf16x8, v0), o0, 0, 0, 0);
            o1 = __builtin_amdgcn_mfma_f32_32x32x16_bf16(__builtin_bit_cast(bf16x8, pa[s]), __builtin_bit_cast(bf16x8, v1), o1, 0, 0, 0);
        }
        asm volatile("s_waitcnt lgkmcnt(0)" ::: "memory");
        sb_dma_tile(Vg + jn * 64, M, vl, lane);
        if (__all(C == 0.0f)) break;
    }
    SB_WAIT_V(0);
    f32x4 nw[8];
    { const float* wv = p.sb_w + h * 64 + (lane & 1) * 32;
#pragma unroll
      for (int j = 0; j < 8; ++j) nw[j] = *(const f32x4*)(wv + 4 * j); }
    LAS float* stg = (LAS float*)wl;
#pragma unroll
    for (int r = 0; r < 16; ++r) { const int row = (r & 3) + 8 * (r >> 2) + 4 * hi; stg[row * SB_STG_PITCH + r32] = o0[r]; stg[row * SB_STG_PITCH + 32 + r32] = o1[r]; }
    asm volatile("s_waitcnt lgkmcnt(0)" ::: "memory");
    {
        const int row = lane >> 1, half = lane & 1;
        f32x4 v[8]; float ss = 0.f;
#pragma unroll
        for (int j = 0; j < 8; ++j) { v[j] = *(const LAS f32x4*)(stg + row * SB_STG_PITCH + half * 32 + 4 * j); ss += v[j][0] * v[j][0] + v[j][1] * v[j][1] + v[j][2] * v[j][2] + v[j][3] * v[j][3]; }
        ss += __shfl_xor(ss, 1);
        const float rs = rsqrtf(ss * (1.0f / 64) + EPS);
        bf16* mo = p.mix() + (tok0 + q0 + row) * DM + h * 64 + half * 32;
#pragma unroll
        for (int j = 0; j < 4; ++j) *(u32x4*)(mo + 8 * j) = pack8(v[2 * j] * rs * nw[2 * j], v[2 * j + 1] * rs * nw[2 * j + 1]);
    }
    asm volatile("s_waitcnt lgkmcnt(0)" ::: "memory");
}
constexpr int SB_WAVES = 6;
__device__ __forceinline__ void ph_sb(const P& p, LAS unsigned char* lds, int bid, int nb) {
    const int tid = phase_tid(), wid = __builtin_amdgcn_readfirstlane(tid >> 6), lane = tid & 63;
    if (wid >= SB_WAVES) return;
    LAS unsigned char* wl = lds + wid * 16384;
    for (int x = bid; x < 256; x += nb) {
        const int bh = x & 63, g = x >> 6;
#pragma unroll 1
        for (int u = wid; u < 32; u += SB_WAVES) {
            const int uq = u >> 3, grp = uq == 0 ? g : uq == 1 ? 7 - g : uq == 2 ? 8 + g : 15 - g;
            sb_unit(p, wl, bh >> 3, bh & 7, grp * 8 + (u & 7), lane);
        }
    }
}
#undef SB_WAIT_V

constexpr int HG_TOT = 0, HG_KUT = 4096, HG_KUT_PITCH = 144, HG_UST = 24576;
constexpr int HG_PITCH = 272, HG_QH = 4096, HG_QI = HG_QH + 64 * HG_PITCH, HG_KH = HG_QI + 64 * HG_PITCH, HG_OST = HG_KH + 64 * HG_PITCH, HG_OST_PITCH = 132;
__device__ __forceinline__ void hg_cumsum(const unsigned (&g)[8], LAS unsigned char* lds, int ch2, int oct, float (&bc0)[8], float (&bc1)[8], float& bl0, float& bl1, float& br0, float& br1) {
    float a0 = 0.f, a1 = 0.f;
#pragma unroll
    for (int i = 0; i < 8; ++i) { typedef _Float16 f16x2 __attribute__((ext_vector_type(2))); const f16x2 kh = __builtin_bit_cast(f16x2, g[i]); a0 += __logf(1.0f - (float)kh.x); a1 += __logf(1.0f - (float)kh.y); bc0[i] = a0; bc1[i] = a1; }
    LAS float* TOT = (LAS float*)(lds + HG_TOT);
    *(LAS f32x2*)(TOT + oct * 128 + ch2) = (f32x2){a0, a1};
    __syncthreads();
    float of0 = 0.f, of1 = 0.f; bl0 = 0.f; bl1 = 0.f; br0 = 0.f; br1 = 0.f;
#pragma unroll
    for (int o = 0; o < 8; ++o) {
        const f32x2 tv = *(const LAS f32x2*)(TOT + o * 128 + ch2);
        if (o < oct) { of0 += tv.x; of1 += tv.y; }
        if (o < 4) { br0 += tv.x; br1 += tv.y; }
        bl0 += tv.x; bl1 += tv.y;
    }
#pragma unroll
    for (int i = 0; i < 8; ++i) { bc0[i] += of0; bc1[i] += of1; }
}
__device__ __forceinline__ float fexp(float x) { return __builtin_amdgcn_exp2f(1.4426950408889634f * x); }
__device__ __forceinline__ float f16lo(unsigned w) { typedef _Float16 f16x2 __attribute__((ext_vector_type(2))); return (float)__builtin_bit_cast(f16x2, w).x; }
__device__ __forceinline__ float f16hi(unsigned w) { typedef _Float16 f16x2 __attribute__((ext_vector_type(2))); return (float)__builtin_bit_cast(f16x2, w).y; }

__device__ __forceinline__ void ph_hg_state(const P& p, LAS unsigned char* lds, int bid, int nb) {
    const int tid = phase_tid(), wid = __builtin_amdgcn_readfirstlane(tid >> 6), lane = tid & 63, r32 = lane & 31, hi = lane >> 5;
    const int ch2 = lane * 2, oct = wid, vt = wid >> 1;
    bf16* U = (bf16*)p.out;
    constexpr int NU = BATCH * HGH * 64;
    unsigned g[8]; bf16x8 af[4];
#define HGS_TOK0(un) ((size_t)(((un) >> 6) >> 2) * SEQ + ((un) & 63) * 64)
#define HGS_LOAD_A(un) do { const size_t t0_ = HGS_TOK0(un); const int h_ = ((un) >> 6) & 3; const _Float16* lf = p.hkf() + t0_ * 512 + h_ * 128; \
        _Pragma("unroll") for (int i = 0; i < 8; ++i) g[i] = *(const unsigned*)(lf + (size_t)(oct * 8 + i) * 512 + ch2); } while (0)
#define HGS_LOAD_B(un) do { const size_t t0_ = HGS_TOK0(un); const int h_ = ((un) >> 6) & 3; const bf16* A = p.vt() + (size_t)(512 + h_ * 128 + vt * 32 + r32) * M + t0_ + hi * 8; \
        _Pragma("unroll") for (int ks = 0; ks < 4; ++ks) af[ks] = *(const bf16x8*)(A + ks * 16); } while (0)
    { const int u0 = bid < NU ? bid : 0; HGS_LOAD_A(u0); __builtin_amdgcn_sched_barrier(0); HGS_LOAD_B(u0); __builtin_amdgcn_sched_barrier(0); }
    for (int unit = bid; unit < NU; unit += nb) {
        const int nxt = unit + nb < NU ? unit + nb : unit;
        float bc0[8], bc1[8], bl0, bl1, br0, br1;
        hg_cumsum(g, lds, ch2, oct, bc0, bc1, bl0, bl1, br0, br1);
        float u0[8], u1[8];
#pragma unroll
        for (int i = 0; i < 8; ++i) { u0[i] = f16lo(g[i]) * fexp(bl0 - bc0[i]); u1[i] = f16hi(g[i]) * fexp(bl1 - bc1[i]); }
        *(LAS u32x4*)(lds + HG_KUT + ch2 * HG_KUT_PITCH + oct * 16) = (u32x4){pk2(u0[0], u0[1]), pk2(u0[2], u0[3]), pk2(u0[4], u0[5]), pk2(u0[6], u0[7])};
        *(LAS u32x4*)(lds + HG_KUT + (ch2 + 1) * HG_KUT_PITCH + oct * 16) = (u32x4){pk2(u1[0], u1[1]), pk2(u1[2], u1[3]), pk2(u1[4], u1[5]), pk2(u1[6], u1[7])};
        if (oct == 0) *(f32x2*)(p.hgd() + (size_t)unit * 128 + ch2) = (f32x2){fexp(bl0), fexp(bl1)};
        __syncthreads();
        HGS_LOAD_A(nxt);
        f32x16 acc[2];
#pragma unroll
        for (int cl = 0; cl < 2; ++cl) {
            const int ct = (wid & 1) * 2 + cl;
#pragma unroll
            for (int r = 0; r < 16; ++r) acc[cl][r] = 0.f;
#pragma unroll
            for (int ks = 0; ks < 4; ++ks) {
                const bf16x8 bf = *(const LAS bf16x8*)(lds + HG_KUT + (ct * 32 + r32) * HG_KUT_PITCH + (ks * 16 + hi * 8) * 2);
                acc[cl] = __builtin_amdgcn_mfma_f32_32x32x16_bf16(af[ks], bf, acc[cl], 0, 0, 0);
            }
        }
        HGS_LOAD_B(nxt);
        { LAS float* st = (LAS float*)(lds + HG_UST + wid * SB_STG_BYTES);
#pragma unroll
          for (int cl = 0; cl < 2; ++cl)
#pragma unroll
              for (int r = 0; r < 16; ++r) st[((r & 3) + 8 * (r >> 2) + 4 * hi) * SB_STG_PITCH + cl * 32 + r32] = acc[cl][r];
          asm volatile("s_waitcnt lgkmcnt(0)" ::: "memory");
          const int row = lane >> 1, half = lane & 1;
          bf16* Uo = U + (size_t)unit * 16384 + (size_t)(vt * 32 + row) * 128 + (wid & 1) * 64 + half * 32;
#pragma unroll
          for (int j = 0; j < 4; ++j) {
              const f32x4 a = *(const LAS f32x4*)(st + row * SB_STG_PITCH + half * 32 + 8 * j), c2 = *(const LAS f32x4*)(st + row * SB_STG_PITCH + half * 32 + 8 * j + 4);
              *(u32x4*)(Uo + 8 * j) = pack8(a, c2);
          }
          asm volatile("s_waitcnt lgkmcnt(0)" ::: "memory"); }
    }
#undef HGS_LOAD_A
#undef HGS_LOAD_B
    __syncthreads();
}
__device__ __forceinline__ void ph_hg_scan(const P& p, int bid, int nb) {
    const bf16* U = (const bf16*)p.out;
    for (int e = bid * NT + threadIdx.x; e < BATCH * HGH * 4096; e += nb * NT) {
        const int bh = e >> 12, v = (e >> 5) & 127, c4 = (e & 31) * 4;
        f32x4 S = {0.f, 0.f, 0.f, 0.f};
        const size_t o0 = (size_t)bh * 64 * 16384 + (size_t)v * 128 + c4;
#pragma unroll 8
        for (int c = 0; c < 64; ++c) {
            const u32x2 uw = *(const u32x2*)(U + o0 + (size_t)c * 16384);
            const f32x4 u = {bflo(uw.x), bfhi(uw.x), bflo(uw.y), bfhi(uw.y)};
            const f32x4 d = *(const f32x4*)(p.hgd() + (size_t)(bh * 64 + c) * 128 + c4);
            u32x2 w; w.x = pk2(S[0], S[1]); w.y = pk2(S[2], S[3]);
            *(u32x2*)(p.sprev() + o0 + (size_t)c * 16384) = w;
            S = d * S + u;
        }
    }
}
__device__ __forceinline__ void ph_hg_out(const P& p, LAS unsigned char* lds, int bid, int nb) {
    const int tid = phase_tid(), wid = __builtin_amdgcn_readfirstlane(tid >> 6), lane = tid & 63, r32 = lane & 31, hi = lane >> 5;
    const int ch2 = lane * 2, oct = wid;
    const int tb = wid >> 2, vb = wid & 3;
    const int tn = tid >> 3, sg = tid & 7;
    constexpr int NU = BATCH * HGH * 64;
    unsigned g[8], qq[8]; bf16x8 bS[8]; u32x2 vl[2][2], vh[2][2]; u32x4 g0, g1; f32x4 w0, w1, w2, w3;
#define HGO_LOAD_A(un) do { const size_t t0_ = HGS_TOK0(un); const int h_ = ((un) >> 6) & 3; const _Float16* lf = p.hkf() + t0_ * 512 + h_ * 128; \
        _Pragma("unroll") for (int i = 0; i < 8; ++i) g[i] = *(const unsigned*)(lf + (size_t)(oct * 8 + i) * 512 + ch2); \
        _Pragma("unroll") for (int i = 0; i < 8; ++i) { const size_t gi = (t0_ + oct * 8 + i) * 512 + h_ * 128 + ch2; qq[i] = *(const unsigned*)(p.hq() + gi); } } while (0)
#define HGO_LOAD_B(un) do { const size_t t0_ = HGS_TOK0(un); const int h_ = ((un) >> 6) & 3; \
        const bf16* Sp = p.sprev() + (size_t)(un) * 16384 + (size_t)(vb * 32 + r32) * 128 + hi * 8; \
        _Pragma("unroll") for (int ks = 0; ks < 8; ++ks) bS[ks] = *(const bf16x8*)(Sp + ks * 16); \
        const bf16* Vt = p.vt() + (size_t)(512 + h_ * 128 + vb * 32 + r32) * M + t0_ + hi * 4; \
        _Pragma("unroll") for (int sb = 0; sb < 2; ++sb) _Pragma("unroll") for (int k2 = 0; k2 < 2; ++k2) { vl[sb][k2] = *(const u32x2*)(Vt + sb * 32 + 16 * k2); vh[sb][k2] = *(const u32x2*)(Vt + sb * 32 + 16 * k2 + 8); } \
        const bf16* gp = p.hgate() + (t0_ + tn) * 512 + h_ * 128 + sg * 16; g0 = *(const u32x4*)(gp); g1 = *(const u32x4*)(gp + 8); \
        const float* wv_ = p.hg_w + h_ * 128 + sg * 16; w0 = *(const f32x4*)(wv_); w1 = *(const f32x4*)(wv_ + 4); w2 = *(const f32x4*)(wv_ + 8); w3 = *(const f32x4*)(wv_ + 12); } while (0)
    { const int u0 = bid < NU ? bid : 0; HGO_LOAD_A(u0); __builtin_amdgcn_sched_barrier(0); HGO_LOAD_B(u0); __builtin_amdgcn_sched_barrier(0); }
    for (int unit = bid; unit < NU; unit += nb) {
        const int nxt = unit + nb < NU ? unit + nb : unit;
        const int h = (unit >> 6) & 3;
        const size_t tok0 = HGS_TOK0(unit);
        float bc0[8], bc1[8], bl0, bl1, br0, br1;
        hg_cumsum(g, lds, ch2, oct, bc0, bc1, bl0, bl1, br0, br1);
#pragma unroll
        for (int i = 0; i < 8; ++i) {
            const int lo = (oct * 8 + i) * HG_PITCH + ch2 * 2;
            *(LAS unsigned*)(lds + HG_QH + lo) = pk2(bflo(qq[i]) * fexp(fminf(bc0[i] - br0, 80.f)), bfhi(qq[i]) * fexp(fminf(bc1[i] - br1, 80.f)));
            *(LAS unsigned*)(lds + HG_QI + lo) = pk2(bflo(qq[i]) * fexp(bc0[i]), bfhi(qq[i]) * fexp(bc1[i]));
            *(LAS unsigned*)(lds + HG_KH + lo) = pk2(f16lo(g[i]) * fexp(fminf(br0 - bc0[i], 80.f)), f16hi(g[i]) * fexp(fminf(br1 - bc1[i], 80.f)));
        }
        __syncthreads();
        HGO_LOAD_A(nxt);
        f32x16 o;
#pragma unroll
        for (int r = 0; r < 16; ++r) o[r] = 0.f;
#pragma unroll
        for (int ks = 0; ks < 8; ++ks) {
            const bf16x8 a = *(const LAS bf16x8*)(lds + HG_QI + (tb * 32 + r32) * HG_PITCH + (ks * 16 + hi * 8) * 2);
            o = __builtin_amdgcn_mfma_f32_32x32x16_bf16(a, bS[ks], o, 0, 0, 0);
        }
#pragma unroll
        for (int sb = 0; sb < 2; ++sb) {
            if (sb <= tb) {
                f32x16 x;
#pragma unroll
                for (int r = 0; r < 16; ++r) x[r] = 0.f;
#pragma unroll
                for (int ks = 0; ks < 8; ++ks) {
                    const bf16x8 a = *(const LAS bf16x8*)(lds + HG_KH + (sb * 32 + r32) * HG_PITCH + (ks * 16 + hi * 8) * 2);
                    const bf16x8 bq = *(const LAS bf16x8*)(lds + HG_QH + (tb * 32 + r32) * HG_PITCH + (ks * 16 + hi * 8) * 2);
                    x = __builtin_amdgcn_mfma_f32_32x32x16_bf16(a, bq, x, 0, 0, 0);
                }
                if (sb == tb) {
#pragma unroll
                    for (int r = 0; r < 16; ++r) { const int sl = (r & 3) + 8 * (r >> 2) + 4 * hi; x[r] = sl <= r32 ? x[r] : 0.f; }
                }
#pragma unroll
                for (int k2 = 0; k2 < 2; ++k2) {
                    const u32x4 pa = {pk2(x[8 * k2], x[8 * k2 + 1]), pk2(x[8 * k2 + 2], x[8 * k2 + 3]), pk2(x[8 * k2 + 4], x[8 * k2 + 5]), pk2(x[8 * k2 + 6], x[8 * k2 + 7])};
                    const u32x4 vv = {vl[sb][k2].x, vl[sb][k2].y, vh[sb][k2].x, vh[sb][k2].y};
                    o = __builtin_amdgcn_mfma_f32_32x32x16_bf16(__builtin_bit_cast(bf16x8, pa), __builtin_bit_cast(bf16x8, vv), o, 0, 0, 0);
                }
            }
        }
        { LAS float* OST = (LAS float*)(lds + HG_OST);
#pragma unroll
          for (int r = 0; r < 16; ++r) OST[(tb * 32 + (r & 3) + 8 * (r >> 2) + 4 * hi) * HG_OST_PITCH + vb * 32 + r32] = o[r]; }
        __syncthreads();
        {
            const LAS float* orow = (const LAS float*)(lds + HG_OST) + tn * HG_OST_PITCH + sg * 16;
            f32x4 v[4]; float ss = 0.f;
#pragma unroll
            for (int j = 0; j < 4; ++j) { v[j] = *(const LAS f32x4*)(orow + 4 * j); ss += v[j][0] * v[j][0] + v[j][1] * v[j][1] + v[j][2] * v[j][2] + v[j][3] * v[j][3]; }
            ss += __shfl_xor(ss, 1); ss += __shfl_xor(ss, 2); ss += __shfl_xor(ss, 4);
            const float rs = rsqrtf(ss * (1.0f / 128) + EPS);
            const int col = h * 128 + sg * 16;
            const f32x4 ga = {bflo(g0.x), bfhi(g0.x), bflo(g0.y), bfhi(g0.y)}, gb = {bflo(g0.z), bfhi(g0.z), bflo(g0.w), bfhi(g0.w)};
            const f32x4 gc = {bflo(g1.x), bfhi(g1.x), bflo(g1.y), bfhi(g1.y)}, gd = {bflo(g1.z), bfhi(g1.z), bflo(g1.w), bfhi(g1.w)};
            const u32x4 r0 = pack8(v[0] * rs * w0 * ga, v[1] * rs * w1 * gb), r1 = pack8(v[2] * rs * w2 * gc, v[3] * rs * w3 * gd);
            HGO_LOAD_B(nxt);
            bf16* mo = p.mix() + (tok0 + tn) * DM + 512 + col;
            *(u32x4*)(mo) = r0; *(u32x4*)(mo + 8) = r1;
        }
    }
#undef HGO_LOAD_A
#undef HGO_LOAD_B
#undef HGS_TOK0
    __syncthreads();
}

__device__ __forceinline__ void ph_route(const P& p, LAS unsigned char* lds, int bid, int nb) {
    const int tid = phase_tid(), wid = __builtin_amdgcn_readfirstlane(tid >> 6), lane = tid & 63, r32 = lane & 31, hi = lane >> 5;
    LAS int* wcnt = (LAS int*)lds; LAS int* wbase = wcnt + 4 * 32;
    for (int bu = bid; bu < M / 128; bu += nb) {
        int m = 0, ex1 = -1, ex2 = -2, off1 = 0, off2 = 0, cnt_mine = 0; float rs = 0.f, g1 = 0.f, g2 = 0.f;
        if (wid < 4) {
            const int wu = bu * 4 + wid;
            m = wu * 32 + r32;
            const bf16* Bp = p.h1b() + (size_t)m * DM + hi * 8; const bf16* Ap = p.wrt() + (size_t)r32 * DM + hi * 8;
            f32x16 a0, a1, a2;
    #pragma unroll
            for (int r = 0; r < 16; ++r) { a0[r] = 0.f; a1[r] = 0.f; a2[r] = 0.f; }
            float ss = 0.f;
    #pragma unroll 8
            for (int ks = 0; ks < 64; ++ks) {
                const u32x4 bw = *(const u32x4*)(Bp + ks * 16);
                ss += bflo(bw.x) * bflo(bw.x) + bfhi(bw.x) * bfhi(bw.x) + bflo(bw.y) * bflo(bw.y) + bfhi(bw.y) * bfhi(bw.y) + bflo(bw.z) * bflo(bw.z) + bfhi(bw.z) * bfhi(bw.z) + bflo(bw.w) * bflo(bw.w) + bfhi(bw.w) * bfhi(bw.w);
                const bf16x8 b = __builtin_bit_cast(bf16x8, bw);
                a0 = __builtin_amdgcn_mfma_f32_32x32x16_bf16(*(const bf16x8*)(Ap + ks * 16), b, a0, 0, 0, 0);
                a1 = __builtin_amdgcn_mfma_f32_32x32x16_bf16(*(const bf16x8*)(Ap + 32 * DM + ks * 16), b, a1, 0, 0, 0);
                a2 = __builtin_amdgcn_mfma_f32_32x32x16_bf16(*(const bf16x8*)(Ap + 64 * DM + ks * 16), b, a2, 0, 0, 0);
            }
            ss += partner32(ss, hi);
            rs = rsqrtf(ss * (1.0f / DM) + EPS);
            float gl[4];
    #pragma unroll
            for (int g = 0; g < 4; ++g) gl[g] = a0[g] * rs + p.bgr[g];
            int gi = 0; float best = gl[0];
    #pragma unroll
            for (int g = 1; g < 4; ++g) if (gl[g] > best) { best = gl[g]; gi = g; }
            float den = 0.f;
    #pragma unroll
            for (int g = 0; g < 4; ++g) den += expf(gl[g] - best);
            const float gprob = 1.0f / den;
            float ig[8], bsel[8];
    #pragma unroll
            for (int e = 0; e < 8; ++e) bsel[e] = p.ber[gi * 8 + e];
    #pragma unroll
            for (int e = 0; e < 8; ++e) {
                const float c0 = a0[4 + e];
                const float c1 = (e < 4 ? a0[(12 + e) & 15] : a1[(e - 4) & 15]);
                const float c2 = a1[4 + e];
                const float c3 = (e < 4 ? a1[(12 + e) & 15] : a2[(e - 4) & 15]);
                ig[e] = (gi == 0 ? c0 : gi == 1 ? c1 : gi == 2 ? c2 : c3) * rs + bsel[e];
            }
            int i1 = 0; float v1 = ig[0];
    #pragma unroll
            for (int e = 1; e < 8; ++e) if (ig[e] > v1) { v1 = ig[e]; i1 = e; }
            int i2 = -1; float v2 = -INFINITY;
    #pragma unroll
            for (int e = 0; e < 8; ++e) if (e != i1 && ig[e] > v2) { v2 = ig[e]; i2 = e; }
            const float e2 = expf(v2 - v1); g1 = gprob / (1.0f + e2); g2 = gprob * e2 / (1.0f + e2);
            ex1 = hi ? -1 : gi * 8 + i1; ex2 = hi ? -2 : gi * 8 + i2;
            cnt_mine = 0; off1 = 0; off2 = 0;
            const unsigned long long below = (1ull << lane) - 1ull;
    #pragma unroll 4
            for (int e = 0; e < NE; ++e) {
                const unsigned long long m1 = __ballot(ex1 == e), m2 = __ballot(ex2 == e);
                const int c1n = __popcll(m1), c2n = __popcll(m2);
                if (lane == e) cnt_mine = c1n + c2n;
                if (ex1 == e) off1 = __popcll(m1 & below);
                if (ex2 == e) off2 = c1n + __popcll(m2 & below);
            }
            if (lane < NE) wcnt[wid * 32 + lane] = cnt_mine;
        }
        __syncthreads();
        if (wid == 0 && lane < NE) {
            const int c0 = wcnt[lane], c1 = wcnt[32 + lane], c2 = wcnt[64 + lane], c3 = wcnt[96 + lane], tot = c0 + c1 + c2 + c3;
            const int base = tot > 0 ? (int)atomicAdd(&p.ctl()[CW_CNT + lane * CNT_STRIDE], (unsigned)tot) : 0;
            wbase[lane] = base; wbase[32 + lane] = base + c0; wbase[64 + lane] = base + c0 + c1; wbase[96 + lane] = base + c0 + c1 + c2;
        }
        __syncthreads();
        if (wid < 4 && hi == 0) {
            const int b1 = wbase[wid * 32 + ex1], b2 = wbase[wid * 32 + ex2];
            p.toke()[2 * m] = ex1; p.toke()[2 * m + 1] = ex2; p.tokr()[2 * m] = b1 + off1; p.tokr()[2 * m + 1] = b2 + off2;
            p.gate()[2 * m] = g1; p.gate()[2 * m + 1] = g2; p.rstd1()[m] = rs;
            p.list()[ex1 * M + b1 + off1] = m; p.list()[ex2 * M + b2 + off2] = m;
        }
        __syncthreads();
    }
}

__device__ void ph_combine(const P& p, const MoeTab* T, int bid, int nb) {
    const int tid = phase_tid(), wave = tid >> 6, lane = tid & 63;
    typedef float f32x2v __attribute__((ext_vector_type(2)));
    for (int m = bid * 8 + wave; m < M; m += nb * 8) {
        const int e0 = p.toke()[2 * m], e1 = p.toke()[2 * m + 1];
        const size_t p0 = (size_t)(T->off[e0] + p.tokr()[2 * m]), p1 = (size_t)(T->off[e1] + p.tokr()[2 * m + 1]);
        const float g0 = p.gate()[2 * m] * (1.0f / FP8_SY), g1 = p.gate()[2 * m + 1] * (1.0f / FP8_SY);
        const u32x4* hr = (const u32x4*)(p.h1b() + (size_t)m * DM);
        const u32x2* y0 = (const u32x2*)(p.y8() + p0 * DM); const u32x2* y1 = (const u32x2*)(p.y8() + p1 * DM);
        u32x4* ho = (u32x4*)(p.h2b() + (size_t)m * DM);
        float ss = 0.f;
#pragma unroll
        for (int j = 0; j < 2; ++j) {
            const u32x4 h = __builtin_nontemporal_load(&hr[lane + 64 * j]); const u32x2 a = __builtin_nontemporal_load(&y0[lane + 64 * j]), b = __builtin_nontemporal_load(&y1[lane + 64 * j]);
            const f32x2v a0 = __builtin_amdgcn_cvt_pk_f32_fp8(a.x, false), a1 = __builtin_amdgcn_cvt_pk_f32_fp8(a.x, true), a2 = __builtin_amdgcn_cvt_pk_f32_fp8(a.y, false), a3 = __builtin_amdgcn_cvt_pk_f32_fp8(a.y, true);
            const f32x2v b0 = __builtin_amdgcn_cvt_pk_f32_fp8(b.x, false), b1 = __builtin_amdgcn_cvt_pk_f32_fp8(b.x, true), b2 = __builtin_amdgcn_cvt_pk_f32_fp8(b.y, false), b3 = __builtin_amdgcn_cvt_pk_f32_fp8(b.y, true);
            f32x4 v0, v1;
            v0[0] = bflo(h.x) + (g0 * a0[0] + g1 * b0[0]); v0[1] = bfhi(h.x) + (g0 * a0[1] + g1 * b0[1]);
            v0[2] = bflo(h.y) + (g0 * a1[0] + g1 * b1[0]); v0[3] = bfhi(h.y) + (g0 * a1[1] + g1 * b1[1]);
            v1[0] = bflo(h.z) + (g0 * a2[0] + g1 * b2[0]); v1[1] = bfhi(h.z) + (g0 * a2[1] + g1 * b2[1]);
            v1[2] = bflo(h.w) + (g0 * a3[0] + g1 * b3[0]); v1[3] = bfhi(h.w) + (g0 * a3[1] + g1 * b3[1]);
            ss += v0[0] * v0[0] + v0[1] * v0[1] + v0[2] * v0[2] + v0[3] * v0[3] + v1[0] * v1[0] + v1[1] * v1[1] + v1[2] * v1[2] + v1[3] * v1[3];
            ho[lane + 64 * j] = pack8(v0, v1);
        }
        ss = wave_sum(ss);
        if (lane == 0) p.rstd2()[m] = rsqrtf(ss * (1.0f / DM) + EPS);
    }
}
__device__ void ph_final(const P& p, int bid, int nb) {
    const int tid = phase_tid(), wave = tid >> 6, lane = tid & 63;
    for (int m = bid * 8 + wave; m < M; m += nb * 8) {
        const u32x4* hr = (const u32x4*)(p.h3b() + (size_t)m * DM);
        f32x4 v[4]; float ss = 0.f;
#pragma unroll
        for (int j = 0; j < 2; ++j) {
            const u32x4 h = __builtin_nontemporal_load(&hr[lane + 64 * j]);
            v[2 * j] = (f32x4){bflo(h.x), bfhi(h.x), bflo(h.y), bfhi(h.y)}; v[2 * j + 1] = (f32x4){bflo(h.z), bfhi(h.z), bflo(h.w), bfhi(h.w)};
        }
#pragma unroll
        for (int j = 0; j < 4; ++j) ss += v[j][0] * v[j][0] + v[j][1] * v[j][1] + v[j][2] * v[j][2] + v[j][3] * v[j][3];
        ss = wave_sum(ss);
        const float r = rsqrtf(ss * (1.0f / DM) + EPS);
        f32x4* orow = (f32x4*)(p.out + (size_t)m * DM);
#pragma unroll
        for (int j = 0; j < 2; ++j) {
            const f32x4 w0 = *(const f32x4*)(p.fin_w + (lane + 64 * j) * 8), w1 = *(const f32x4*)(p.fin_w + (lane + 64 * j) * 8 + 4);
            __builtin_nontemporal_store(v[2 * j] * r * w0, &orow[(lane + 64 * j) * 2]); __builtin_nontemporal_store(v[2 * j + 1] * r * w1, &orow[(lane + 64 * j) * 2 + 1]);
        }
    }
}

constexpr int CW_BAR = 4096;
constexpr size_t CTL_ZERO_BYTES = 64 * 1024;

__global__ void __launch_bounds__(NT, 2) fwd_megakernel(P p) {
    extern __shared__ __attribute__((aligned(16))) unsigned char lds_raw[];
    LAS unsigned char* lds3 = (LAS unsigned char*)lds_raw;
    volatile LAS unsigned* MISC = (volatile LAS unsigned*)(lds3 + MISC_OFF);
    MoeTab* T = (MoeTab*)(lds_raw + TAB_OFF);
    if (threadIdx.x < 32) MISC[threadIdx.x] = 0u;
    __syncthreads();
    XcdBarrier bar = xcd_barrier_post(p.ctl() + CW_BAR, MISC + 8);
    const int bid = blockIdx.x, nb = gridDim.x;
    ph_prep_weights<false>(p, lds3, bid, nb, 0, T_DENSE_ITEMS, 0, 8);
    ph_prep_router(p, bid, nb);
    ph_prep_rows(p, bid, nb);
    xcd_barrier(bar);
    { pg8::DenseOrder S; S.init(p.xn(), p.win(), M, INC - 1024, DM, nb, bid); EpiInProj E{p}; pg8::gemm_phase(lds3, DM, S, E); }
    { pg8::DenseOrder S; S.init(p.win() + (size_t)(INC - 1024) * DM, p.xn(), 1024, M, DM, nb, bid); EpiVT E{p}; pg8::gemm_phase(lds3, DM, S, E); }
    xcd_barrier(bar);
    ph_hg_state(p, lds3, bid, nb);
    ph_sb(p, lds3, bid, nb);
    ph_prep_weights<true>(p, lds3, bid, nb, T_DENSE_ITEMS, T_NITEMS, SB_WAVES, 8 - SB_WAVES);
    xcd_barrier(bar);
    ph_hg_scan(p, bid, nb);
    xcd_barrier(bar);
    ph_hg_out(p, lds3, bid, nb);
    xcd_barrier(bar);
    { pg8::DenseOrder S; S.init(p.mix(), p.wout(), M, DM, DM, nb, bid); EpiOutProj E{p}; pg8::gemm_phase(lds3, DM, S, E); }
    xcd_barrier(bar);
    ph_route(p, lds3, bid, nb);
    xcd_barrier(bar);
    moe_tab(p, T);
    moe_fill_tables(p, T, lds3, bid, nb);
    { MoeOrder S{(const LAS int*)(lds3 + UDESC_OFF), (const char*)p.h1q(), (const char*)p.wgu8(), (size_t)DM, (size_t)DM * DM, (size_t)256 * DM}; EpiMoeUp E{p, (const LAS float*)(lds3 + GTAB_OFF + GTAB_UNITS * 1024)};
      int k8 = DM / 2; asm volatile("" : "+s"(k8));
      pg8::gemm_phase<true, true>(lds3, k8, S, E, (const char*)p.h1q(), (const LAS int*)(lds3 + GTAB_OFF)); }
    xcd_barrier(bar);
    { MoeOrder S{(const LAS int*)(lds3 + UDESC_OFF), (const char*)p.act8(), (const char*)p.wd8(), (size_t)DE, (size_t)DM * DE, (size_t)256 * DE}; EpiMoeDown E{p}; int k8 = DE / 2; asm volatile("" : "+s"(k8)); pg8::gemm_phase<false, true>(lds3, k8, S, E); }
    xcd_barrier(bar);
    ph_combine(p, T, bid, nb);
    xcd_barrier(bar);
    { int kple = PLE; asm volatile("" : "+s"(kple)); pg8::DenseOrder S; S.init(p.pb(), p.wpp_t(), M, DM, kple, nb, bid); EpiPleE E{p}; pg8::gemm_phase(lds3, kple, S, E); }
    { pg8::DenseOrder S; S.init(p.h2b(), p.wpg_t(), M, DM, DM, nb, bid); EpiPleGate E{p}; pg8::gemm_phase(lds3, DM, S, E); }
    xcd_barrier(bar);
    ph_final(p, bid, nb);
}

extern "C" void kernel_launch(void* const* d_in, const int* in_sizes, int n_in, void* d_out, int out_size, void* d_ws, size_t ws_size, hipStream_t stream) {
    if (n_in != 20 || out_size != M * DM || ws_size < WS_END) { fprintf(stderr, "kernel_launch: unexpected shapes (n_in %d, out %d, ws %zu)\n", n_in, out_size, ws_size); return; }
    P p{};
    const float** f = (const float**)&p;
    for (int i = 0; i < 20; ++i) f[i] = (const float*)d_in[i];
    unsigned char* ws = (unsigned char*)d_ws;
    p.out = (float*)d_out; p.ws = ws;
    static int grid = 0;
    if (grid == 0) {
        int dev = 0, cus = 0, per_cu = 0;
        if (hipGetDevice(&dev) != hipSuccess || hipDeviceGetAttribute(&cus, hipDeviceAttributeMultiprocessorCount, dev) != hipSuccess) { fprintf(stderr, "kernel_launch: device query failed\n"); grid = -1; return; }
        if (hipFuncSetAttribute((const void*)fwd_megakernel, hipFuncAttributeMaxDynamicSharedMemorySize, LDS_BYTES) != hipSuccess) { fprintf(stderr, "kernel_launch: hipFuncSetAttribute failed\n"); grid = -1; return; }
        if (hipOccupancyMaxActiveBlocksPerMultiprocessor(&per_cu, (const void*)fwd_megakernel, NT, LDS_BYTES) != hipSuccess || per_cu < 1) { fprintf(stderr, "kernel_launch: occupancy query reports %d workgroups per CU\n", per_cu); }
        (void)hipGetLastError();
        grid = cus;
    }
    if (grid < 0) return;
    if (hipMemsetAsync(ws + WS_CTL, 0, CTL_ZERO_BYTES, stream) != hipSuccess) { fprintf(stderr, "kernel_launch: memset failed\n"); return; }
    hipLaunchKernelGGL(fwd_megakernel, dim3(grid), dim3(NT), LDS_BYTES, stream, p);
}
```

```cpp
#include <hip/hip_runtime.h>
#include <cstdio>
#include <cstdint>


constexpr int BATCH = 8, SEQ = 4096, DM = 1024, M = BATCH * SEQ;
constexpr int SBW = 512, SBH = 8, SBD = 64;
constexpr int HGW = 512, HGH = 4, HGD = 128;
constexpr int PLE = 256, NG = 4, EPG = 8, NE = 32, DE = 512, INC = 3584;
constexpr float EPS = 1e-6f;
constexpr int NT = 512;

typedef unsigned short bf16;
__device__ __forceinline__ bf16 f2bf(float f) { unsigned u = __float_as_uint(f); return (bf16)((u + 0x7fffu + ((u >> 16) & 1u)) >> 16); }
__device__ __forceinline__ float bf2f(bf16 h) { return __uint_as_float(((unsigned)h) << 16); }
__device__ __forceinline__ float bflo(unsigned w) { return __uint_as_float(w << 16); }
__device__ __forceinline__ float bfhi(unsigned w) { return __uint_as_float(w & 0xffff0000u); }
typedef float f32x2_t __attribute__((ext_vector_type(2))); typedef __bf16 bf16x2_t __attribute__((ext_vector_type(2)));
__device__ __forceinline__ unsigned pk2(float lo, float hi) { const f32x2_t v = {lo, hi}; const bf16x2_t b = __builtin_convertvector(v, bf16x2_t); return __builtin_bit_cast(unsigned, b); }
__device__ __forceinline__ int phase_tid() { int t = threadIdx.x; asm volatile("" : "+v"(t)); return t; }
constexpr float FP8_SH = 16.f, FP8_SW1 = 512.f, FP8_SA = 16.f, FP8_SW2 = 256.f, FP8_SY = 32.f;
__device__ __forceinline__ unsigned pk4_fp8(float a, float b, float c, float d) {
    a = __builtin_amdgcn_fmed3f(a, -448.f, 448.f); b = __builtin_amdgcn_fmed3f(b, -448.f, 448.f); c = __builtin_amdgcn_fmed3f(c, -448.f, 448.f); d = __builtin_amdgcn_fmed3f(d, -448.f, 448.f);
    unsigned w = 0; w = __builtin_amdgcn_cvt_pk_fp8_f32(a, b, w, false); w = __builtin_amdgcn_cvt_pk_fp8_f32(c, d, w, true); return w;
}
__device__ __forceinline__ float wave_sum(float v) {
#pragma unroll
    for (int o = 1; o < 64; o <<= 1) v += __shfl_xor(v, o);
    return v;
}
__device__ __forceinline__ float sigmoidf_(float x) { return 1.0f / (1.0f + expf(-x)); }

constexpr size_t MiB = 1u << 20;
constexpr size_t WS_CTL = 0;
constexpr size_t WS_LB = 1 * MiB;
constexpr size_t WS_RSTD1 = 1 * MiB + 64 * 1024;
constexpr size_t WS_RSTD2 = 1 * MiB + 256 * 1024;
constexpr size_t WS_XNORM = 1 * MiB + 512 * 1024;
constexpr size_t WS_TOKE = 2 * MiB;
constexpr size_t WS_TOKR = 2 * MiB + 512 * 1024;
constexpr size_t WS_GATE = 3 * MiB;
constexpr size_t WS_LIST = 4 * MiB;
constexpr size_t WS_WBF = 8 * MiB;
constexpr size_t WS_PB = 116 * MiB;
constexpr size_t WS_XN = 132 * MiB;
constexpr size_t WS_MIX = 132 * MiB;
constexpr size_t WS_H2B = 132 * MiB;
constexpr size_t WS_SBQ = 196 * MiB, WS_SBK = 228 * MiB;
constexpr size_t WS_VT = 260 * MiB;
constexpr size_t WS_HQ = 324 * MiB, WS_HK = 356 * MiB, WS_HGATE = 388 * MiB;
constexpr size_t WS_LOGF = 420 * MiB;
constexpr size_t WS_HGD = 484 * MiB;
constexpr size_t WS_SPREV = 196 * MiB;
constexpr size_t WS_H1B = 196 * MiB;
constexpr size_t WS_EST = 196 * MiB;
constexpr size_t WS_XS = 260 * MiB;
constexpr size_t WS_Y = 260 * MiB;
constexpr size_t WS_ACT = 390 * MiB;
constexpr size_t WS_H1Q = 324 * MiB;
constexpr size_t WS_H3B = 260 * MiB;
constexpr size_t WS_RSS = 3 * MiB + 512 * 1024;
constexpr size_t WS_END = 486 * MiB;
constexpr size_t WS_WIN = 8 * MiB, WS_WOUT = 15 * MiB, WS_WPG = 17 * MiB, WS_WPP = 19 * MiB, WS_WRT = 19 * MiB + 512 * 1024, WS_WGU = 20 * MiB, WS_WD = 84 * MiB;
constexpr int CW_CNT = 64, CNT_STRIDE = 64;

struct P {
    const float *x, *p, *attn_w, *w_in, *sb_w, *hg_lb, *hg_w, *w_out, *ffn_w, *wgr, *bgr, *wer, *ber, *weg, *weu, *wed, *ple_w, *wpp, *wpg, *fin_w;
    float* out;
    unsigned char* ws;
    __device__ __forceinline__ unsigned* ctl() const { return (unsigned*)(ws + WS_CTL); }
    __device__ __forceinline__ float* lb() const { return (float*)(ws + WS_LB); }
    __device__ __forceinline__ float* rstd1() const { return (float*)(ws + WS_RSTD1); }
    __device__ __forceinline__ float* rstd2() const { return (float*)(ws + WS_RSTD2); }
    __device__ __forceinline__ float* gate() const { return (float*)(ws + WS_GATE); }
    __device__ __forceinline__ _Float16* hkf() const { return (_Float16*)(ws + WS_LOGF); }
    __device__ __forceinline__ int* toke() const { return (int*)(ws + WS_TOKE); }
    __device__ __forceinline__ int* tokr() const { return (int*)(ws + WS_TOKR); }
    __device__ __forceinline__ int* list() const { return (int*)(ws + WS_LIST); }
    __device__ __forceinline__ bf16* pb() const { return (bf16*)(ws + WS_PB); }
    __device__ __forceinline__ bf16* xn() const { return (bf16*)(ws + WS_XN); }
    __device__ __forceinline__ bf16* mix() const { return (bf16*)((unsigned char*)out + 64 * MiB); }
    __device__ __forceinline__ float* xnorm() const { return (float*)(ws + WS_XNORM); }
    __device__ __forceinline__ bf16* h2b() const { return (bf16*)(ws + WS_H2B); }
    __device__ __forceinline__ bf16* sbq() const { return (bf16*)(ws + WS_SBQ); }
    __device__ __forceinline__ bf16* sbk() const { return (bf16*)(ws + WS_SBK); }
    __device__ __forceinline__ bf16* vt() const { return (bf16*)(ws + WS_VT); }
    __device__ __forceinline__ bf16* sprev() const { return (bf16*)(ws + WS_SPREV); }
    __device__ __forceinline__ float* hgd() const { return (float*)(ws + WS_HGD); }
    __device__ __forceinline__ bf16* hq() const { return (bf16*)(ws + WS_HQ); }
    __device__ __forceinline__ bf16* hk() const { return (bf16*)(ws + WS_HK); }
    __device__ __forceinline__ bf16* hgate() const { return (bf16*)(ws + WS_HGATE); }
    __device__ __forceinline__ bf16* h1b() const { return (bf16*)(ws + WS_H1B); }
    __device__ __forceinline__ bf16* act() const { return (bf16*)(ws + WS_ACT); }
    __device__ __forceinline__ bf16* y() const { return (bf16*)(ws + WS_Y); }
    __device__ __forceinline__ bf16* est() const { return (bf16*)(ws + WS_EST); }
    __device__ __forceinline__ bf16* win() const { return (bf16*)(ws + WS_WIN); }
    __device__ __forceinline__ bf16* wout() const { return (bf16*)(ws + WS_WOUT); }
    __device__ __forceinline__ bf16* wpg_t() const { return (bf16*)(ws + WS_WPG); }
    __device__ __forceinline__ bf16* wpp_t() const { return (bf16*)(ws + WS_WPP); }
    __device__ __forceinline__ bf16* h3b() const { return (bf16*)(ws + WS_H3B); }
    __device__ __forceinline__ unsigned char* h1q() const { return ws + WS_H1Q; }
    __device__ __forceinline__ unsigned char* wgu8() const { return ws + WS_WGU; }
    __device__ __forceinline__ unsigned char* wd8() const { return ws + WS_WD; }
    __device__ __forceinline__ unsigned char* h2q() const { return ws + WS_ACT; }
    __device__ __forceinline__ unsigned char* wpg8() const { return ws + WS_WPG; }
    __device__ __forceinline__ unsigned char* act8() const { return ws + WS_ACT; }
    __device__ __forceinline__ unsigned char* y8() const { return ws + WS_Y; }
    __device__ __forceinline__ bf16* wrt() const { return (bf16*)(ws + WS_WRT); }
};

constexpr int LDS_BYTES = 147456, MISC_OFF = 131072 + 320, TAB_OFF = 131072 + 1024, GTAB_OFF = 131072 + 2048, GTAB_UNITS = 6, UDESC_OFF = 131072 + 2048 + 12288;

constexpr int PREP_ROW_WAVES = 6;
__device__ __forceinline__ void ph_prep_rows(const P& p, int bid, int nb) {
    const int tid = phase_tid(), wave = tid >> 6, lane = tid & 63;
    if (bid == 0 && wave >= PREP_ROW_WAVES) {
        for (int c = tid - PREP_ROW_WAVES * 64; c < HGW; c += NT - PREP_ROW_WAVES * 64) {
            const float a = p.hg_lb[c], b = p.hg_lb[HGW + c], mx = fmaxf(a, b);
            const float ea = expf(a - mx), eb = expf(b - mx);
            p.lb()[c] = ea / (ea + eb);
        }
    }
    if (wave >= PREP_ROW_WAVES) return;
    const int gw = bid * PREP_ROW_WAVES + wave, ngw = nb * PREP_ROW_WAVES;
    for (int m = gw; m < M; m += ngw) {
        const float4* xr = (const float4*)(p.x + (size_t)m * DM);
        float4 v[4]; float ss = 0.f;
#pragma unroll
        for (int j = 0; j < 4; ++j) { { typedef float f4_t __attribute__((ext_vector_type(4))); const f4_t t4 = __builtin_nontemporal_load((const f4_t*)xr + lane + 64 * j); v[j] = make_float4(t4[0], t4[1], t4[2], t4[3]); } ss += v[j].x * v[j].x + v[j].y * v[j].y + v[j].z * v[j].z + v[j].w * v[j].w; }
        ss = wave_sum(ss);
        const float ms = ss * (1.0f / DM) + EPS, r = rsqrtf(ms);
        uint2* o = (uint2*)(p.xn() + (size_t)m * DM);
#pragma unroll
        for (int j = 0; j < 4; ++j) {
            uint2 t; t.x = pk2(v[j].x * r, v[j].y * r); t.y = pk2(v[j].z * r, v[j].w * r);
            o[lane + 64 * j] = t;
        }
        if (lane == 0) p.xnorm()[m] = __builtin_sqrtf(ms);
    }
    const size_t n4 = (size_t)M * PLE / 4, pstride = (size_t)nb * (PREP_ROW_WAVES * 64);
    typedef float f4_t __attribute__((ext_vector_type(4)));
    for (size_t i0 = (size_t)bid * (PREP_ROW_WAVES * 64) + tid; i0 < n4; i0 += 4 * pstride) {
        f4_t t4[4];
#pragma unroll
        for (int j = 0; j < 4; ++j) { const size_t i = i0 + j * pstride; t4[j] = __builtin_nontemporal_load((const f4_t*)p.p + (i < n4 ? i : i0)); }
#pragma unroll
        for (int j = 0; j < 4; ++j) { const size_t i = i0 + j * pstride; if (i < n4) { uint2 t; t.x = pk2(t4[j][0], t4[j][1]); t.y = pk2(t4[j][2], t4[j][3]); ((uint2*)p.pb())[i] = t; } }
    }
}

#define LAS __attribute__((address_space(3)))
#define XB_TMO      128
#define XB_XCNT(j)  (256  + 64 * (j))
#define XB_XSUB(j)  (1280 + 64 * (j))
#define XB_XGEN(j)  (2304 + 64 * (j))
#define XB_TOP      3328
#define XB_TOPGEN   3392
#define XCD_BAR_WORDS 3456
#define XB_SPIN_CAP (1u << 18)
__device__ __forceinline__ unsigned xb_ld(unsigned* p)              { return __hip_atomic_load(p, __ATOMIC_RELAXED, __HIP_MEMORY_SCOPE_AGENT); }
__device__ __forceinline__ unsigned xb_add(unsigned* p, unsigned v) { return __hip_atomic_fetch_add(p, v, __ATOMIC_RELAXED, __HIP_MEMORY_SCOPE_AGENT); }
__device__ __forceinline__ unsigned xb_xcc_id() { return (unsigned)__builtin_amdgcn_s_getreg((3 << 11) | 20) & 0xFu; }
#define XB_SPIN(cond, bar) do { unsigned _sp = 0; while (cond) { __builtin_amdgcn_s_sleep(1); \
    if ((++_sp & 255u) == 0u) { if (xb_ld(&(bar)[XB_TMO])) break; if (_sp > XB_SPIN_CAP) { atomicAdd(&(bar)[XB_TMO], 1u); break; } } } } while (0)
struct XcdBarrier { unsigned* bar; unsigned x; volatile LAS unsigned* st; };
__device__ __forceinline__ XcdBarrier xcd_barrier_post(unsigned* bar, volatile LAS unsigned* st) {
    XcdBarrier b; b.bar = bar; b.x = xb_xcc_id(); b.st = st;
    if (threadIdx.x == 0) (void)xb_add(&bar[XB_XCNT(b.x)], 1u);
    return b;
}
__device__ __forceinline__ void xcd_barrier_complete(unsigned* bar, unsigned x, unsigned& nloc, unsigned& nx) {
    const unsigned G = gridDim.x * gridDim.y * gridDim.z;
    unsigned sum, cnt, mine, sp = 0u;
    for (;;) {
        sum = 0u; cnt = 0u; mine = 0u;
#pragma unroll
        for (unsigned j = 0; j < 16; ++j) { const unsigned c = xb_ld(&bar[XB_XCNT(j)]); sum += c; cnt += (c > 0u) ? 1u : 0u; mine = (j == x) ? c : mine; }
        if (sum == G) break;
        __builtin_amdgcn_s_sleep(1);
        if ((++sp & 255u) == 0u) { if (xb_ld(&bar[XB_TMO])) break; if (sp > XB_SPIN_CAP) { atomicAdd(&bar[XB_TMO], 1u); break; } }
    }
    nloc = mine > 0u ? mine : 1u; nx = cnt > 0u ? cnt : 1u;
}
__device__ __forceinline__ void xcd_barrier(const XcdBarrier& b) {
    asm volatile("s_waitcnt vmcnt(0)" ::: "memory");
    __syncthreads();
    if (threadIdx.x == 0) {
        unsigned* bar = b.bar;
        __builtin_amdgcn_s_waitcnt(0);
        unsigned nloc = b.st[0], nx = b.st[1];
        if (nloc == 0u) { xcd_barrier_complete(bar, b.x, nloc, nx); b.st[0] = nloc; b.st[1] = nx; }
        const unsigned old = xb_add(&bar[XB_XSUB(b.x)], 1u);
        const unsigned gen = old / nloc;
        if (old + 1u == (gen + 1u) * nloc) {
            __builtin_amdgcn_fence(__ATOMIC_RELEASE, "agent");
            asm volatile("s_waitcnt vmcnt(0)" ::: "memory");
            const unsigned og = xb_add(&bar[XB_TOP], 1u);
            const unsigned tg = og / nx;
            if (og + 1u == (tg + 1u) * nx) xb_add(&bar[XB_TOPGEN], 1u);
            else XB_SPIN(xb_ld(&bar[XB_TOPGEN]) == tg, bar);
            __builtin_amdgcn_fence(__ATOMIC_ACQUIRE, "agent");
            xb_add(&bar[XB_XGEN(b.x)], 1u);
            asm volatile("s_waitcnt vmcnt(0)" ::: "memory");
        } else {
            XB_SPIN(xb_ld(&bar[XB_XGEN(b.x)]) == gen, bar);
            __builtin_amdgcn_fence(__ATOMIC_ACQUIRE, "agent");
            asm volatile("s_waitcnt vmcnt(0)" ::: "memory");
        }
    }
    __syncthreads();
}


namespace pg8 {
#define PG8_LAS __attribute__((address_space(3)))
typedef short bf16x8 __attribute__((ext_vector_type(8)));
typedef float f32x4 __attribute__((ext_vector_type(4)));
typedef unsigned u32x4 __attribute__((ext_vector_type(4)));
typedef int i32x8 __attribute__((ext_vector_type(8)));
typedef int i32x4 __attribute__((ext_vector_type(4)));
constexpr int BM = 256, BK = 64, HALF = 128, HTB = HALF * BK * 2  , STAGE_BYTES = 8 * HTB, NXCD = 8, WGM = 8;
__host__ __device__ __forceinline__ int lds_byte(int r, int c) { const int st = (r >> 4) * 2 + (c >> 5), rr = r & 15, cc = c & 31, ob = rr * 64 + cc * 2; return st * 1024 + (ob ^ (((ob >> 9) & 1) << 5)); }
__host__ __device__ __forceinline__ void stage_rc(int b, int& R, int& C) { const int st = b / 1024, sb = b % 1024, swz = sb ^ (((sb >> 9) & 1) << 5); R = (st >> 1) * 16 + swz / 64; C = (st & 1) * 32 + (swz % 64) / 2; }
__host__ __device__ __forceinline__ int perm32(int rho) { const int n = rho >> 4, i = rho & 15; return 8 * (i >> 2) + 4 * n + (i & 3); }

struct Unit { const char* A; const char* B; int row0, pn, valid, aux; };

template <bool GATHER = false, bool FP8 = false, class Epi, class Sched>
__device__ __forceinline__ void gemm_phase(PG8_LAS unsigned char* lds, const int K, const Sched& S, const Epi& E, const char* A0 = nullptr, const PG8_LAS int* gtab = nullptr) {
    const int tid = phase_tid(), wid = __builtin_amdgcn_readfirstlane(tid >> 6), lane = tid & 63, wr = wid >> 2, wc = wid & 3, fr = lane & 15, fq = lane >> 4;
    const int nt = K / BK;
    unsigned voffA[2], voffB[2];
#pragma unroll
    for (int i = 0; i < 2; ++i) { int R, C; stage_rc(tid * 16 + i * 8192, R, C); const int Rb = (R & ~31) + perm32(R & 31);
        voffA[i] = (unsigned)(R * K + C) * 2u; voffB[i] = (unsigned)(Rb * K + C) * 2u; }
    const size_t kstep = (size_t)(BK * 2);
    const size_t hstep = (size_t)HALF * K * 2;
    const unsigned ldsw = (unsigned)wid * 1024u;
    const int fcol = fq * 8;
    const int aoff = lds_byte(wr * 64 + fr, fcol), boff = lds_byte(wc * 32 + fr, fcol);
#define PG8_SA(b, h) (((b) * 2 + (h)) * HTB)
#define PG8_SB(b, h) ((4 + (b) * 2 + (h)) * HTB)
#define PG8_STAGE(bufoff, gbase, voff) do { _Pragma("unroll") for (int _i = 0; _i < 2; ++_i) \
        __builtin_amdgcn_global_load_lds((const unsigned*)((const char*)(gbase) + (voff)[_i]), (PG8_LAS unsigned*)(lds + (bufoff) + ldsw + _i * 8192), 16, 0, 0); } while (0)
#define PG8_LDA(dst, b, h) do { if constexpr (FP8) { _Pragma("unroll") for (int m = 0; m < 4; ++m) dst##8[m] = __builtin_shufflevector(*(const PG8_LAS i32x4*)(lds + PG8_SA(b, h) + aoff + m * 2048), *(const PG8_LAS i32x4*)(lds + PG8_SA(b, h) + aoff + m * 2048 + 1024), 0, 1, 2, 3, 4, 5, 6, 7); } \
        else { _Pragma("unroll") for (int m = 0; m < 4; ++m) _Pragma("unroll") for (int k = 0; k < 2; ++k) dst[m][k] = *(const PG8_LAS bf16x8*)(lds + PG8_SA(b, h) + aoff + m * 2048 + k * 1024); } } while (0)
#define PG8_LDB(dst, b, h) do { if constexpr (FP8) { _Pragma("unroll") for (int n = 0; n < 2; ++n) dst##8[n] = __builtin_shufflevector(*(const PG8_LAS i32x4*)(lds + PG8_SB(b, h) + boff + n * 2048), *(const PG8_LAS i32x4*)(lds + PG8_SB(b, h) + boff + n * 2048 + 1024), 0, 1, 2, 3, 4, 5, 6, 7); } \
        else { _Pragma("unroll") for (int n = 0; n < 2; ++n) _Pragma("unroll") for (int k = 0; k < 2; ++k) dst[n][k] = *(const PG8_LAS bf16x8*)(lds + PG8_SB(b, h) + boff + n * 2048 + k * 1024); } } while (0)
#define PG8_MMA(ai, bj, At, Bt) do { __builtin_amdgcn_s_setprio(1); _Pragma("unroll") for (int m = 0; m < 4; ++m) _Pragma("unroll") for (int n = 0; n < 2; ++n) { \
        if constexpr (FP8) asm volatile("v_mfma_f32_16x16x128_f8f6f4 %0, %1, %2, %0" : "+v"(acc[ai][bj][m][n]) : "v"(Bt##8[n]), "v"(At##8[m]));   \
        else { _Pragma("unroll") for (int k = 0; k < 2; ++k) acc[ai][bj][m][n] = __builtin_amdgcn_mfma_f32_16x16x32_bf16(Bt[n][k], At[m][k], acc[ai][bj][m][n], 0, 0, 0); } } \
        __builtin_amdgcn_s_setprio(0); } while (0)
#define PG8_WAIT_V(n) asm volatile("s_waitcnt vmcnt(" #n ")" ::: "memory")
#define PG8_WAIT_L(n) asm volatile("s_waitcnt lgkmcnt(" #n ")" ::: "memory")
#define PG8_BAR __builtin_amdgcn_s_barrier()
#define PG8_SCHED __builtin_amdgcn_sched_barrier(0)
    Unit cur, nxt; int ui = 0;
    if (!S.next(0, cur)) return;
    unsigned goff[2][2] = {{0u, 0u}, {0u, 0u}};
#define PG8_GLOAD(un) do { const PG8_LAS int* t_ = gtab + (un) * 256; \
        _Pragma("unroll") for (int i_ = 0; i_ < 2; ++i_) { int R_, C_; stage_rc(tid * 16 + i_ * 8192, R_, C_); \
            goff[0][i_] = (unsigned)t_[R_] * (unsigned)(2 * K) + (unsigned)(2 * C_); goff[1][i_] = (unsigned)t_[128 + R_] * (unsigned)(2 * K) + (unsigned)(2 * C_); } } while (0)
    if constexpr (GATHER) PG8_GLOAD(0);
#define PG8_STAGE_A(bufoff, kp, h) do { if constexpr (GATHER) PG8_STAGE(bufoff, kp, goff[h]); else PG8_STAGE(bufoff, (kp) + (h) * hstep, voffA); } while (0)
    f32x4 acc[2][2][4][2];
#pragma unroll
    for (int a = 0; a < 2; ++a)
#pragma unroll
        for (int b = 0; b < 2; ++b)
#pragma unroll
            for (int m = 0; m < 4; ++m)
#pragma unroll
                for (int n = 0; n < 2; ++n) acc[a][b][m][n] = (f32x4){0.f, 0.f, 0.f, 0.f};
    bf16x8 At[4][2], B0[2][2], B1[2][2];
    i32x8 At8[4], B08[2], B18[2];
    const char* cA = GATHER ? A0 : cur.A; const char* cB = cur.B;
    PG8_STAGE(PG8_SB(0, 0), cB, voffB); PG8_STAGE(PG8_SB(0, 1), cB + hstep, voffB); PG8_STAGE_A(PG8_SA(0, 0), cA, 0); PG8_STAGE_A(PG8_SA(0, 1), cA, 1);
    if (wr == 1) PG8_BAR;
    PG8_WAIT_V(2); PG8_BAR;
    PG8_STAGE(PG8_SB(1, 0), cB + kstep, voffB); PG8_STAGE_A(PG8_SA(1, 0), cA + kstep, 0); PG8_STAGE(PG8_SB(1, 1), cB + hstep + kstep, voffB);
    PG8_WAIT_V(6); PG8_BAR;
    for (;;) {
        const bool has_next = S.next(ui + 1, nxt);
        const bool upper = cur.valid > HALF;
        const char* nA = GATHER ? A0 : (has_next ? nxt.A : cA); const char* nB = has_next ? nxt.B : cB;
#pragma unroll 1
        for (int t = 0; t < nt; t += 2) {
            const bool last = (t == nt - 2);
            const char* a1 = cA + (size_t)(t + 1) * kstep;
            const char* a2 = last ? nA : cA + (size_t)(t + 2) * kstep; const char* b2 = last ? nB : cB + (size_t)(t + 2) * kstep;
            const char* a3 = a2 + kstep; const char* b3 = b2 + kstep;
            PG8_LDB(B0, 0, 0); PG8_LDB(B1, 0, 1); PG8_SCHED; PG8_LDA(At, 0, 0); PG8_STAGE_A(PG8_SA(1, 1), a1, 1);
            if constexpr (GATHER) { if (last && has_next) PG8_GLOAD(ui + 1); }
            PG8_WAIT_V(8); PG8_WAIT_L(0); PG8_BAR; PG8_MMA(0, 0, At, B0); PG8_MMA(0, 1, At, B1); PG8_BAR; PG8_SCHED;
            PG8_LDA(At, 0, 1); PG8_STAGE(PG8_SB(0, 0), b2, voffB); PG8_STAGE(PG8_SB(0, 1), b2 + hstep, voffB); PG8_STAGE_A(PG8_SA(0, 0), a2, 0);
            PG8_WAIT_V(8); PG8_WAIT_L(0); PG8_BAR; if (!FP8 || upper) { PG8_MMA(1, 0, At, B0); PG8_MMA(1, 1, At, B1); } PG8_BAR; PG8_SCHED;
            PG8_LDB(B0, 1, 0); PG8_LDB(B1, 1, 1); PG8_SCHED; PG8_LDA(At, 1, 0); PG8_STAGE_A(PG8_SA(0, 1), a2, 1);
            PG8_WAIT_V(8); PG8_WAIT_L(0); PG8_BAR; PG8_MMA(0, 0, At, B0); PG8_MMA(0, 1, At, B1); PG8_BAR; PG8_SCHED;
            PG8_LDA(At, 1, 1); PG8_STAGE(PG8_SB(1, 0), b3, voffB); PG8_STAGE(PG8_SB(1, 1), b3 + hstep, voffB); PG8_STAGE_A(PG8_SA(1, 0), a3, 0);
            PG8_WAIT_V(8); PG8_WAIT_L(0); PG8_BAR; if (!FP8 || upper) { PG8_MMA(1, 0, At, B0); PG8_MMA(1, 1, At, B1); } PG8_BAR; PG8_SCHED;
        }
        if (wr == 0) PG8_BAR;
        if constexpr (FP8) asm volatile("s_nop 15\n\ts_nop 15" ::: "memory");
        E(acc, cur, wr, wc, fr, fq);
        if (!has_next) break;
#pragma unroll
        for (int a = 0; a < 2; ++a)
#pragma unroll
            for (int b = 0; b < 2; ++b)
#pragma unroll
                for (int m = 0; m < 4; ++m)
#pragma unroll
                    for (int n = 0; n < 2; ++n) acc[a][b][m][n] = (f32x4){0.f, 0.f, 0.f, 0.f};
        cur = nxt; cA = nA; cB = nB; ++ui;
        if (wr == 1) PG8_BAR;
    }
    PG8_WAIT_V(0);
    PG8_BAR;
#undef PG8_SA
#undef PG8_SB
#undef PG8_STAGE
#undef PG8_STAGE_A
#undef PG8_GLOAD
#undef PG8_LDA
#undef PG8_LDB
#undef PG8_MMA
#undef PG8_WAIT_V
#undef PG8_WAIT_L
#undef PG8_BAR
#undef PG8_SCHED
}

struct DenseOrder {
    const char* A; const char* B; int nM, nN, nwg, G, c, wgm; size_t tstep;
    __device__ void init(const void* A_, const void* B_, int M_, int N_, int K_, int G_, int c_, int wgm_ = WGM) { A = (const char*)A_; B = (const char*)B_; nM = M_ / BM; nN = N_ / BM; nwg = nM * nN; G = G_; c = c_; wgm = wgm_; tstep = (size_t)BM * K_ * 2; }
    __device__ bool next(int i, Unit& u) const {
        const long L = (long)i * G + c; if (L >= nwg) return false;
        int wgid = (int)L; { const int q = nwg / NXCD, r = nwg % NXCD, xcd = wgid % NXCD, off = wgid / NXCD; wgid = (xcd < r ? xcd * (q + 1) : r * (q + 1) + (xcd - r) * q) + off; }
        const int nig = wgm * nN, gid = wgid / nig, fm = gid * wgm, gsz = (nM - fm) < wgm ? (nM - fm) : wgm;
        const int pm = fm + ((wgid % nig) % gsz), pn = (wgid % nig) / gsz;
        u.A = A + (size_t)pm * tstep; u.B = B + (size_t)pn * tstep; u.row0 = pm * BM; u.pn = pn; u.valid = BM; u.aux = 0; return true;
    }
};
}

typedef float f32x4 __attribute__((ext_vector_type(4)));
typedef unsigned u32x4 __attribute__((ext_vector_type(4)));
typedef unsigned u32x2 __attribute__((ext_vector_type(2)));
typedef float f32x2 __attribute__((ext_vector_type(2)));
constexpr float QSCALE = 0.125f * 1.4426950408889634f;
__device__ __forceinline__ float fsigmoid(float x) { return __builtin_amdgcn_rcpf(1.0f + __builtin_amdgcn_exp2f(-1.4426950408889634f * x)); }

struct MoeTab { int cnt[NE], off[NE + 1], tpre[NE + 1]; unsigned char tile_e[320]; };
__device__ __forceinline__ void moe_tab(const P& p, MoeTab* T) {
    __syncthreads();
    if (threadIdx.x < 64) {
        const int lane = threadIdx.x;
        const int c = lane < NE ? (int)__hip_atomic_load(&p.ctl()[CW_CNT + lane * CNT_STRIDE], __ATOMIC_RELAXED, __HIP_MEMORY_SCOPE_AGENT) : 0;
        const int nt_ = (c + 255) / 256;
        int so = c, st = nt_;
#pragma unroll
        for (int d = 1; d < 32; d <<= 1) { const int a_ = __shfl_up(so, d), b_ = __shfl_up(st, d); if (lane >= d) { so += a_; st += b_; } }
        if (lane < NE) {
            T->cnt[lane] = c; T->off[lane] = so - c; T->tpre[lane] = st - nt_;
            for (int j = 0; j < nt_; ++j) T->tile_e[st - nt_ + j] = (unsigned char)lane;
        }
        if (lane == NE - 1) { T->off[NE] = so; T->tpre[NE] = st; }
    }
    __syncthreads();
}
__device__ __forceinline__ bool moe_unit(const MoeTab* T, int i, int c, int G, int& mt, int& pn, int& half) {
    half = -1;
    const int ntl = T->tpre[NE];
    if ((G & 31) == 0) {
        const int per = G >> 3, mpg = per >> 2, x = c & 7, j = c >> 3, RT = 8 * mpg, R = ntl / RT, rem = ntl - R * RT;
        if (i == R && rem <= per) { const int g = j >> 3, k = j & 7, rt = g * 8 + x; mt = R * RT + rt; pn = k & 3; half = k >> 2; return rt < rem; }
        mt = (i * 8 + x) * mpg + (j >> 2); pn = j & 3;
    }
    else { const int L = i * G + c; mt = L >> 2; pn = L & 3; }
    return mt < ntl;
}
struct MoeOrder {
    const LAS int* ud; const char* A; const char* B; size_t a_pitch, b_exp; size_t b_tile;
    __device__ bool next(int i, pg8::Unit& u) const {
        if (i >= GTAB_UNITS) return false;
        const int row0 = ud[4 * i], valid = ud[4 * i + 1], e = ud[4 * i + 2], pn = ud[4 * i + 3];
        if (valid == 0) return false;
        u.row0 = row0; u.valid = valid; u.pn = pn; u.aux = i;
        u.A = A + (size_t)row0 * a_pitch; u.B = B + (size_t)e * b_exp + (size_t)pn * b_tile; return true;
    }
};

#define EPI_FR int frl_ = fr; asm volatile("" : "+v"(frl_));
#define EPI_ROWS_BEGIN _Pragma("unroll") for (int ai = 0; ai < 2; ++ai) _Pragma("unroll") for (int m = 0; m < 4; ++m) { const int rt = ai * 128 + wr * 64 + m * 16 + frl_;
#define EPI_ROWS_END }
__device__ __forceinline__ u32x4 pack8(const f32x4 a, const f32x4 b) { u32x4 w; w.x = pk2(a[0], a[1]); w.y = pk2(a[2], a[3]); w.z = pk2(b[0], b[1]); w.w = pk2(b[2], b[3]); return w; }

struct EpiInProj {
    P p;
    template <int SEG>
    __device__ __forceinline__ void rows(const f32x4 (&acc)[2][2][4][2], const pg8::Unit& u, int wr, int frl_, int cb, bf16* dst) const {
#pragma unroll
        for (int bj = 0; bj < 2; ++bj) {
            const int c = cb + bj * 128;
            f32x4 l0 = {0.f, 0.f, 0.f, 0.f}, l1 = l0;
            if (SEG == 3) { l0 = *(const f32x4*)(p.lb() + c); l1 = *(const f32x4*)(p.lb() + c + 4); asm volatile("" : "+v"(l0), "+v"(l1)); }
            EPI_ROWS_BEGIN
                const size_t o = (size_t)(u.row0 + rt) * 512 + c;
                f32x4 v0 = acc[ai][bj][m][0], v1 = acc[ai][bj][m][1];
                if (SEG == 0) { v0 = v0 * QSCALE; v1 = v1 * QSCALE; }
                else if (SEG == 2 || SEG == 4) {
#pragma unroll
                    for (int q = 0; q < 4; ++q) { v0[q] = v0[q] * fsigmoid(v0[q]); v1[q] = v1[q] * fsigmoid(v1[q]); }
                } else if (SEG == 3) {
#pragma unroll
                    for (int q = 0; q < 4; ++q) { v0[q] = (1.0f - l0[q]) * fsigmoid(-v0[q]); v1[q] = (1.0f - l1[q]) * fsigmoid(-v1[q]); }
                    typedef _Float16 f16x8 __attribute__((ext_vector_type(8)));
                    *(f16x8*)(p.hkf() + o) = (f16x8){(_Float16)v0[0], (_Float16)v0[1], (_Float16)v0[2], (_Float16)v0[3], (_Float16)v1[0], (_Float16)v1[1], (_Float16)v1[2], (_Float16)v1[3]};
                }
                if (SEG != 3) *(u32x4*)(dst + o) = pack8(v0, v1);
            EPI_ROWS_END
        }
    }
    __device__ __forceinline__ void operator()(const f32x4 (&acc)[2][2][4][2], const pg8::Unit& u, int wr, int wc, int fr, int fq) const {
        EPI_FR
        const int colt = u.pn * 256, seg = colt >> 9, cb = (colt & 511) + wc * 32 + 8 * fq;
        if (seg == 0) rows<0>(acc, u, wr, frl_, cb, p.sbq());
        else if (seg == 1) rows<1>(acc, u, wr, frl_, cb, p.sbk());
        else if (seg == 2) rows<2>(acc, u, wr, frl_, cb, p.hq());
        else if (seg == 3) rows<3>(acc, u, wr, frl_, cb, nullptr);
        else rows<4>(acc, u, wr, frl_, cb, p.hgate());
    }
};
struct EpiVT {
    P p;
    __device__ __forceinline__ void operator()(const f32x4 (&acc)[2][2][4][2], const pg8::Unit& u, int wr, int wc, int fr, int fq) const {
        EPI_FR
#pragma unroll
        for (int bj = 0; bj < 2; ++bj) {
            const int c = u.pn * 256 + bj * 128 + wc * 32 + 8 * fq;
            EPI_ROWS_BEGIN *(u32x4*)(p.vt() + (size_t)(u.row0 + rt) * M + c) = pack8(acc[ai][bj][m][0], acc[ai][bj][m][1]); EPI_ROWS_END
        }
    }
};
struct EpiOutProj {
    P p;
    __device__ __forceinline__ void operator()(const f32x4 (&acc)[2][2][4][2], const pg8::Unit& u, int wr, int wc, int fr, int fq) const {
        EPI_FR
        const int cb = u.pn * 256 + wc * 32 + 8 * fq;
        u32x4 xa[2][4]; float xr[2][4];
#define OP_LD(b, s) _Pragma("unroll") for (int m = 0; m < 4; ++m) { const int row = u.row0 + ((b) & 1) * 128 + wr * 64 + m * 16 + frl_; \
            xr[s][m] = p.xnorm()[row]; xa[s][m] = *(const u32x4*)(p.xn() + (size_t)row * DM + cb + ((b) >> 1) * 128); }
#define OP_CS(b, s) _Pragma("unroll") for (int m = 0; m < 4; ++m) { const size_t o = (size_t)(u.row0 + ((b) & 1) * 128 + wr * 64 + m * 16 + frl_) * DM + cb + ((b) >> 1) * 128; \
            const u32x4 xw = xa[s][m]; const float sc_ = xr[s][m]; \
            const f32x4 h0 = (f32x4){bflo(xw.x), bfhi(xw.x), bflo(xw.y), bfhi(xw.y)} * sc_ + acc[(b) & 1][(b) >> 1][m][0], h1 = (f32x4){bflo(xw.z), bfhi(xw.z), bflo(xw.w), bfhi(xw.w)} * sc_ + acc[(b) & 1][(b) >> 1][m][1]; \
            *(u32x4*)(p.h1b() + o) = pack8(h0, h1); \
            const f32x4 q0 = h0 * FP8_SH, q1 = h1 * FP8_SH; \
            *(u32x2*)(p.h1q() + o) = (u32x2){pk4_fp8(q0[0], q0[1], q0[2], q0[3]), pk4_fp8(q1[0], q1[1], q1[2], q1[3])}; }
        OP_LD(0, 0) OP_LD(1, 1) OP_CS(0, 0) OP_LD(2, 0) OP_CS(1, 1) OP_LD(3, 1) OP_CS(2, 0) OP_CS(3, 1)
#undef OP_LD
#undef OP_CS
    }
};
struct EpiMoeUp {
    P p; const LAS float* rtab;
    __device__ __forceinline__ void operator()(const f32x4 (&acc)[2][2][4][2], const pg8::Unit& u, int wr, int wc, int fr, int fq) const {
        EPI_FR
        const int c = u.pn * 128 + wc * 32 + 8 * fq;
        EPI_ROWS_BEGIN
            if (rt < u.valid) {
                const float rs = rtab[u.aux * 256 + rt] * (1.0f / (FP8_SH * FP8_SW1));
                f32x4 a0, a1;
#pragma unroll
                for (int q = 0; q < 4; ++q) {
                    const float g0 = acc[ai][0][m][0][q] * rs, g1 = acc[ai][0][m][1][q] * rs;
                    a0[q] = g0 * fsigmoid(g0) * (acc[ai][1][m][0][q] * rs) * FP8_SA; a1[q] = g1 * fsigmoid(g1) * (acc[ai][1][m][1][q] * rs) * FP8_SA;
                }
                *(u32x2*)(p.act8() + (size_t)(u.row0 + rt) * DE + c) = (u32x2){pk4_fp8(a0[0], a0[1], a0[2], a0[3]), pk4_fp8(a1[0], a1[1], a1[2], a1[3])};
            }
        EPI_ROWS_END
    }
};
struct EpiMoeDown {
    P p;
    __device__ __forceinline__ void operator()(const f32x4 (&acc)[2][2][4][2], const pg8::Unit& u, int wr, int wc, int fr, int fq) const {
        EPI_FR
        constexpr float sc = FP8_SY / (FP8_SA * FP8_SW2);
#pragma unroll
        for (int bj = 0; bj < 2; ++bj) {
            const int c = u.pn * 256 + bj * 128 + wc * 32 + 8 * fq;
            EPI_ROWS_BEGIN
                if (rt < u.valid) { const f32x4 a = acc[ai][bj][m][0] * sc, b = acc[ai][bj][m][1] * sc;
                    *(u32x2*)(p.y8() + (size_t)(u.row0 + rt) * DM + c) = (u32x2){pk4_fp8(a[0], a[1], a[2], a[3]), pk4_fp8(b[0], b[1], b[2], b[3])}; }
            EPI_ROWS_END
        }
    }
};
struct EpiPleE {
    P p;
    __device__ __forceinline__ void operator()(const f32x4 (&acc)[2][2][4][2], const pg8::Unit& u, int wr, int wc, int fr, int fq) const {
        EPI_FR
#pragma unroll
        for (int bj = 0; bj < 2; ++bj) {
            const int c = u.pn * 256 + bj * 128 + wc * 32 + 8 * fq;
            EPI_ROWS_BEGIN *(u32x4*)(p.est() + (size_t)(u.row0 + rt) * DM + c) = pack8(acc[ai][bj][m][0], acc[ai][bj][m][1]); EPI_ROWS_END
        }
    }
};
struct EpiPleGate {
    P p;
    __device__ __forceinline__ void operator()(const f32x4 (&acc)[2][2][4][2], const pg8::Unit& u, int wr, int wc, int fr, int fq) const {
        EPI_FR
        const int cb = u.pn * 256 + wc * 32 + 8 * fq;
        u32x4 ev[2][4], hv[2][4]; float rv[2][4];
#define PG_LD(b, s) _Pragma("unroll") for (int m = 0; m < 4; ++m) { const int row = u.row0 + ((b) & 1) * 128 + wr * 64 + m * 16 + frl_; const size_t o = (size_t)row * DM + cb + ((b) >> 1) * 128; \
            rv[s][m] = p.rstd2()[row]; ev[s][m] = *(const u32x4*)(p.est() + o); hv[s][m] = *(const u32x4*)(p.h2b() + o); }
#define PG_CS(b, s) _Pragma("unroll") for (int m = 0; m < 4; ++m) { const size_t o = (size_t)(u.row0 + ((b) & 1) * 128 + wr * 64 + m * 16 + frl_) * DM + cb + ((b) >> 1) * 128; \
            const float rs = rv[s][m] * (1.0f / (FP8_SH * FP8_SW1)); const u32x4 e = ev[s][m], hb = hv[s][m]; \
            const f32x4 g0 = acc[(b) & 1][(b) >> 1][m][0], g1 = acc[(b) & 1][(b) >> 1][m][1]; \
            f32x4 h0, h1; \
            h0[0] = bflo(hb.x) + fsigmoid(g0[0] * rs) * bflo(e.x); h0[1] = bfhi(hb.x) + fsigmoid(g0[1] * rs) * bfhi(e.x); h0[2] = bflo(hb.y) + fsigmoid(g0[2] * rs) * bflo(e.y); h0[3] = bfhi(hb.y) + fsigmoid(g0[3] * rs) * bfhi(e.y); \
            h1[0] = bflo(hb.z) + fsigmoid(g1[0] * rs) * bflo(e.z); h1[1] = bfhi(hb.z) + fsigmoid(g1[1] * rs) * bfhi(e.z); h1[2] = bflo(hb.w) + fsigmoid(g1[2] * rs) * bflo(e.w); h1[3] = bfhi(hb.w) + fsigmoid(g1[3] * rs) * bfhi(e.w); \
            *(u32x4*)(p.h3b() + o) = pack8(h0, h1); }
        PG_LD(0, 0) PG_CS(0, 0) PG_LD(1, 1) PG_LD(2, 0) PG_CS(1, 1) PG_LD(3, 1) PG_CS(2, 0) PG_CS(3, 1)
#undef PG_LD
#undef PG_CS
    }
};

struct TItem { const float* W; bf16* WT; unsigned char* WT8; const float* ks; const float* dummy; float wscale; int K, N, rowmode, k0, n0; };
__device__ __forceinline__ TItem t_decode(const P& p, int it) {
    constexpr int I_IN = 16 * (INC / 64), I_SQ = 16 * 16, I_PP = 4 * 16, I_G = 16 * 8, I_D = 8 * 16;
    TItem t; int r = it; t.WT8 = nullptr; t.wscale = 1.f; t.dummy = p.attn_w;
    if (r < I_IN) { t.W = p.w_in; t.WT = p.win(); t.ks = p.attn_w; t.K = DM; t.N = INC; t.rowmode = 3; }
    else if ((r -= I_IN) < I_SQ) { t.W = p.w_out; t.WT = p.wout(); t.ks = nullptr; t.K = DM; t.N = DM; t.rowmode = 0; }
    else if ((r -= I_SQ) < I_PP) { t.W = p.wpp; t.WT = p.wpp_t(); t.ks = nullptr; t.K = PLE; t.N = DM; t.rowmode = 0; }
    else if ((r -= I_PP) < I_SQ) { t.W = p.wpg; t.WT = nullptr; t.WT8 = p.wpg8(); t.wscale = FP8_SW1; t.ks = p.ple_w; t.K = DM; t.N = DM; t.rowmode = 0; }
    else {
        r -= I_SQ; const int e = r / (2 * I_G + I_D); r -= e * (2 * I_G + I_D);
        if (r < I_G) { t.W = p.weg + (size_t)e * DM * DE; t.WT = nullptr; t.WT8 = p.wgu8() + (size_t)e * DM * DM; t.wscale = FP8_SW1; t.ks = p.ffn_w; t.K = DM; t.N = DE; t.rowmode = 1; }
        else if ((r -= I_G) < I_G) { t.W = p.weu + (size_t)e * DM * DE; t.WT = nullptr; t.WT8 = p.wgu8() + (size_t)e * DM * DM; t.wscale = FP8_SW1; t.ks = p.ffn_w; t.K = DM; t.N = DE; t.rowmode = 2; }
        else { r -= I_G; t.W = p.wed + (size_t)e * DE * DM; t.WT = nullptr; t.WT8 = p.wd8() + (size_t)e * DM * DE; t.wscale = FP8_SW2; t.ks = nullptr; t.K = DE; t.N = DM; t.rowmode = 0; }
    }
    const int nblk = t.N / 64; t.k0 = 64 * (r / nblk); t.n0 = 64 * (r % nblk);
    return t;
}
__device__ __forceinline__ void t_load(const TItem& t, f32x4 (&v)[16], f32x4 (&sc)[2], int lane) {
    const int lr = lane >> 4, c4 = lane & 15;
#pragma unroll
    for (int i = 0; i < 16; ++i) v[i] = *(const f32x4*)(t.W + (size_t)(t.k0 + 4 * i + lr) * t.N + t.n0 + c4 * 4);
    const float* ksp = (t.ks ? t.ks : t.dummy) + t.k0 + 8 * (lane & 7); const float use = t.ks ? 1.f : 0.f, one = 1.f - use;
    sc[0] = *(const f32x4*)(ksp) * use + one; sc[1] = *(const f32x4*)(ksp + 4) * use + one;
}
__device__ __forceinline__ void t_store(const TItem& t, f32x4 (&v)[16], const f32x4 (&sc)[2], LAS float* scr, int lane) {
    const int lr = lane >> 4, c4 = lane & 15;
#pragma unroll
    for (int i = 0; i < 16; ++i) {
        const int kk = 4 * i + lr;
        *(LAS f32x4*)(scr + kk * 64 + ((c4 ^ ((kk >> 3) & 7)) << 2)) = v[i];
    }
    asm volatile("s_waitcnt lgkmcnt(0)" ::: "memory");
    const int n0 = t.n0, seg3 = n0 >> 9, dseg3 = seg3 < 2 ? seg3 : seg3 == 2 ? 5 : seg3 == 3 ? 2 : seg3 == 4 ? 3 : seg3 == 5 ? 6 : 4;
    const int rbase = t.rowmode == 0 ? n0 : t.rowmode == 3 ? dseg3 * 512 + (n0 & 511) : (n0 >> 7) * 256 + (n0 & 127) + (t.rowmode == 2 ? 128 : 0);
    const int c = lane & 7;
#pragma unroll
    for (int j = 0; j < 8; ++j) {
        const int n = (lane >> 3) + 8 * j;
        const LAS float* s = scr + (8 * c) * 64 + ((((n >> 2) ^ c) << 2) | (n & 3));
        u32x4 o; o.x = pk2(s[0] * sc[0][0], s[64] * sc[0][1]); o.y = pk2(s[128] * sc[0][2], s[192] * sc[0][3]); o.z = pk2(s[256] * sc[1][0], s[320] * sc[1][1]); o.w = pk2(s[384] * sc[1][2], s[448] * sc[1][3]);
        *(u32x4*)(t.WT + (size_t)(rbase + n) * t.K + t.k0 + 8 * c) = o;
    }
    asm volatile("s_waitcnt lgkmcnt(0)" ::: "memory");
}
__device__ __forceinline__ void t_load8(const TItem& t, f32x4 (&v)[16], f32x4 (&sc)[4], int lane) {
    const int lr = lane >> 4, c4 = lane & 15;
#pragma unroll
    for (int i = 0; i < 16; ++i) v[i] = __builtin_nontemporal_load((const f32x4*)(t.W + (size_t)(t.k0 + 4 * i + lr) * t.N + t.n0 + c4 * 4));
#pragma unroll
    for (int q = 0; q < 4; ++q) sc[q] = *(const f32x4*)((t.ks ? t.ks : t.dummy) + t.k0 + 16 * (lane & 3) + 4 * q);
}
__device__ __forceinline__ void t_store8(const TItem& t, f32x4 (&v)[16], const f32x4 (&sc)[4], LAS float* scr, int lane) {
    const int lr = lane >> 4, c4 = lane & 15;
#pragma unroll
    for (int i = 0; i < 16; ++i) {
        const int kk = 4 * i + lr;
        *(LAS f32x4*)(scr + kk * 64 + ((c4 ^ ((kk >> 3) & 7)) << 2)) = v[i];
    }
    asm volatile("s_waitcnt lgkmcnt(0)" ::: "memory");
    const int n0 = t.n0;
    const int rbase = t.rowmode == 0 ? n0 : (n0 >> 7) * 256 + (n0 & 127) + (t.rowmode == 2 ? 128 : 0);
    const float ksu = t.ks ? t.wscale : 0.f, ksc = t.ks ? 0.f : t.wscale;
    const int c = lane & 3;
#pragma unroll
    for (int j = 0; j < 4; ++j) {
        const int n = (lane >> 2) + 16 * j;
        float w[16];
#pragma unroll
        for (int q = 0; q < 16; ++q) { const int sw = (2 * c + (q >> 3)) & 7; w[q] = scr[(16 * c + q) * 64 + ((((n >> 2) ^ sw) << 2) | (n & 3))] * (sc[q >> 2][q & 3] * ksu + ksc); }
        const u32x4 o = {pk4_fp8(w[0], w[1], w[2], w[3]), pk4_fp8(w[4], w[5], w[6], w[7]), pk4_fp8(w[8], w[9], w[10], w[11]), pk4_fp8(w[12], w[13], w[14], w[15])};
        __builtin_nontemporal_store(o, (u32x4*)(t.WT8 + (size_t)(rbase + n) * t.K + t.k0 + 16 * c));
    }
    asm volatile("s_waitcnt lgkmcnt(0)" ::: "memory");
}
constexpr int T_NITEMS = 16 * (INC / 64) + 2 * 256 + 64 + NE * (2 * 128 + 128), T_DENSE_ITEMS = 16 * (INC / 64) + 256 + 64;
template <bool F8>
__device__ __forceinline__ void ph_prep_weights(const P& p, LAS unsigned char* lds, int bid, int nb, int lo, int hi, int w0, int nw) {
    const int tid = phase_tid(), wave = __builtin_amdgcn_readfirstlane(tid >> 6), lane = tid & 63;
    if (wave < w0 || wave >= w0 + nw) return;
    LAS float* scr = (LAS float*)(lds + wave * 16384);
    const int gw = bid * nw + (wave - w0), ngw = nb * nw;
    f32x4 va[16], vb[16], sa[4], sb[4];
    int it = lo + gw;
    if (it >= hi) return;
    TItem ta = t_decode(p, it), tb = ta;
#define T_LOAD(t, v, s) do { if constexpr (F8) t_load8(t, v, s, lane); else t_load(t, v, (f32x4(&)[2])s, lane); } while (0)
#define T_STORE(t, v, s) do { if constexpr (F8) t_store8(t, v, s, scr, lane); else t_store(t, v, (const f32x4(&)[2])s, scr, lane); } while (0)
    T_LOAD(ta, va, sa);
    __builtin_amdgcn_sched_barrier(0);
    for (; it < hi; it += 2 * ngw) {
        const int i1 = it + ngw, i2 = it + 2 * ngw;
        tb = t_decode(p, i1 < hi ? i1 : it); T_LOAD(tb, vb, sb);
        __builtin_amdgcn_sched_barrier(0);
        T_STORE(ta, va, sa);
        ta = t_decode(p, i2 < hi ? i2 : it); T_LOAD(ta, va, sa);
        __builtin_amdgcn_sched_barrier(0);
        if (i1 < hi) T_STORE(tb, vb, sb);
    }
#undef T_LOAD
#undef T_STORE
}

__device__ __forceinline__ void ph_prep_router(const P& p, int bid, int nb) {
    for (int i = bid * NT + threadIdx.x; i < 96 * DM; i += nb * NT) {
        const int row = i >> 10, k = i & 1023, tau = row >> 5, rho = row & 31;
        float v = 0.f;
        if ((rho & 4) == 0) {
            const int r = (rho & 3) + 4 * (rho >> 3), L = tau * 16 + r;
            if (L < 4) v = p.ffn_w[k] * p.wgr[k * 4 + L]; else if (L < 36) v = p.ffn_w[k] * p.wer[k * 32 + L - 4];
        }
        p.wrt()[i] = f2bf(v);
    }
}

__device__ __forceinline__ void moe_fill_tables(const P& p, const MoeTab* T, LAS unsigned char* lds, int bid, int nb) {
    LAS int* gtab = (LAS int*)(lds + GTAB_OFF); LAS float* rtab = (LAS float*)(lds + GTAB_OFF + GTAB_UNITS * 1024); LAS int* ud = (LAS int*)(lds + UDESC_OFF);
    const int tid = phase_tid();
    int ue[GTAB_UNITS], ur0[GTAB_UNITS], ucnt[GTAB_UNITS], tok[GTAB_UNITS]; bool uok[GTAB_UNITS];
#pragma unroll
    for (int i = 0; i < GTAB_UNITS; ++i) {
        int mt, pn, half;
        uok[i] = moe_unit(T, i, bid, nb, mt, pn, half);
        const int e = uok[i] ? (int)T->tile_e[mt] : 0;
        ue[i] = e; ur0[i] = uok[i] ? (mt - T->tpre[e]) * 256 + (half > 0 ? 128 : 0) : 0; ucnt[i] = uok[i] ? T->cnt[e] : 1;
        const int rem = ucnt[i] - ur0[i], vmax = half >= 0 ? 128 : 256;
        if (rem <= 0) uok[i] = false;
        if (tid == 0) { ud[4 * i] = T->off[e] + ur0[i]; ud[4 * i + 1] = uok[i] ? (rem < vmax ? rem : vmax) : 0; ud[4 * i + 2] = e; ud[4 * i + 3] = pn; }
    }
    if (tid < 256) {
#pragma unroll
        for (int i = 0; i < GTAB_UNITS; ++i) {
            int rk = ur0[i] + tid; if (rk >= ucnt[i]) rk = ucnt[i] - 1;
            tok[i] = uok[i] ? p.list()[ue[i] * M + rk] : 0;
        }
        float rsv[GTAB_UNITS];
#pragma unroll
        for (int i = 0; i < GTAB_UNITS; ++i) rsv[i] = p.rstd1()[tok[i]];
#pragma unroll
        for (int i = 0; i < GTAB_UNITS; ++i) if (uok[i]) { gtab[i * 256 + tid] = tok[i]; rtab[i * 256 + tid] = rsv[i]; }
    }
    __syncthreads();
}

typedef short bf16x8 __attribute__((ext_vector_type(8)));
typedef float f32x16 __attribute__((ext_vector_type(16)));
constexpr int SB_STG_PITCH = 68, SB_STG_BYTES = 32 * SB_STG_PITCH * 4;
__device__ __forceinline__ float partner32(float x, int hi) {
    const unsigned xb = __float_as_uint(x);
    const auto rr = __builtin_amdgcn_permlane32_swap(xb, xb, false, false);
    (void)hi;
    return __uint_as_float(rr[0] != xb ? rr[0] : rr[1]);
}
#define SB_WAIT_V(n) asm volatile("s_waitcnt vmcnt(" #n ")" ::: "memory")
__device__ __forceinline__ void sb_dma_tile(const bf16* g, size_t row_pitch, LAS unsigned char* l, int lane) {
    const int p = lane & 7;
#pragma unroll
    for (int i = 0; i < 8; ++i) {
        const int row = 8 * i + (lane >> 3), c = p ^ ((row >> 1) & 7);
        __builtin_amdgcn_global_load_lds((const unsigned*)(g + (size_t)row * row_pitch + c * 8), (LAS unsigned*)(l + i * 1024), 16, 0, 0);
    }
}
constexpr float SB_STOP = 1e-9f;
__device__ __forceinline__ void sb_unit(const P& p, LAS unsigned char* wl, int b, int h, int qblk, int lane) {
    const int r32 = lane & 31, hi = lane >> 5, q0 = qblk * 32, swr = (r32 >> 1) & 7;
    const size_t tok0 = (size_t)b * SEQ;
    const bf16* Kg = p.sbk() + tok0 * 512 + h * 64;
    const bf16* Vg = p.vt() + (size_t)(h * 64) * M + tok0;
    LAS unsigned char* kl = wl; LAS unsigned char* vl = wl + 8192;
    const int jdiag = (q0 + 31) >> 6;
    sb_dma_tile(Kg + (size_t)jdiag * 64 * 512, 512, kl, lane);
    sb_dma_tile(Vg + jdiag * 64, M, vl, lane);
    bf16x8 qf[4];
    {
        const bf16* Qp = p.sbq() + (tok0 + q0 + r32) * 512 + h * 64 + hi * 8;
#pragma unroll
        for (int d0 = 0; d0 < 4; ++d0) qf[d0] = *(const bf16x8*)(Qp + d0 * 16);
    }
    f32x16 o0, o1;
#pragma unroll
    for (int r = 0; r < 16; ++r) { o0[r] = 0.f; o1[r] = 0.f; }
    float C = 1.0f;
    const int t = q0 + r32;
    const LAS unsigned char* kr = kl + r32 * 128; const LAS unsigned char* vr = vl + r32 * 128 + hi * 8;
    for (int jt = jdiag; jt >= 0; --jt) {
        const int kv0 = jt * 64, jn = jt > 0 ? jt - 1 : 0;
        SB_WAIT_V(8);
        bf16x8 kf[8];
#pragma unroll
        for (int d0 = 0; d0 < 4; ++d0) {
            kf[2 * d0] = *(const LAS bf16x8*)(kr + (((2 * d0 + hi) ^ swr) << 4));
            kf[2 * d0 + 1] = *(const LAS bf16x8*)(kr + 32 * 128 + (((2 * d0 + hi) ^ swr) << 4));
        }
        f32x16 p0, p1;
#pragma unroll
        for (int r = 0; r < 16; ++r) { p0[r] = 0.f; p1[r] = 0.f; }
#pragma unroll
        for (int d0 = 0; d0 < 4; ++d0) {
            p0 = __builtin_amdgcn_mfma_f32_32x32x16_bf16(kf[2 * d0], qf[d0], p0, 0, 0, 0);
            p1 = __builtin_amdgcn_mfma_f32_32x32x16_bf16(kf[2 * d0 + 1], qf[d0], p1, 0, 0, 0);
        }
        asm volatile("s_waitcnt lgkmcnt(0)" ::: "memory");
        sb_dma_tile(Kg + (size_t)jn * 64 * 512, 512, kl, lane);
        f32x16 b0, b1;
#pragma unroll
        for (int r = 0; r < 16; ++r) {
            const float e0 = __builtin_amdgcn_exp2f(p0[r]), e1 = __builtin_amdgcn_exp2f(p1[r]);
            const float r0 = __builtin_amdgcn_rcpf(1.0f + e0), r1 = __builtin_amdgcn_rcpf(1.0f + e1);
            p0[r] = r0; p1[r] = r1; b0[r] = 1.0f - r0; b1[r] = 1.0f - r1;
        }
        if (jt == jdiag) {
#pragma unroll
            for (int r = 0; r < 16; ++r) {
                const int kv = kv0 + (r & 3) + 8 * (r >> 2) + 4 * hi;
                if (kv >= t) { p0[r] = 1.0f; b0[r] = 0.f; }
                if (kv + 32 >= t) { p1[r] = 1.0f; b1[r] = 0.f; }
            }
        }
        float T[8], X[8];
#pragma unroll
        for (int i = 0; i < 4; ++i) { T[i] = (p0[4 * i] * p0[4 * i + 1]) * (p0[4 * i + 2] * p0[4 * i + 3]); T[4 + i] = (p1[4 * i] * p1[4 * i + 1]) * (p1[4 * i + 2] * p1[4 * i + 3]); }
        float suf = 1.0f;
#pragma unroll
        for (int i = 7; i >= 0; --i) {
            const float part = partner32(T[i], hi);
            X[i] = (hi ? suf : suf * part) * C;
            suf *= T[i] * part;
        }
        C *= suf;
#pragma unroll
        for (int i = 0; i < 4; ++i) {
            float w = X[i];
            b0[4 * i + 3] *= w; w *= p0[4 * i + 3]; b0[4 * i + 2] *= w; w *= p0[4 * i + 2]; b0[4 * i + 1] *= w; w *= p0[4 * i + 1]; b0[4 * i] *= w;
            w = X[4 + i];
            b1[4 * i + 3] *= w; w *= p1[4 * i + 3]; b1[4 * i + 2] *= w; w *= p1[4 * i + 2]; b1[4 * i + 1] *= w; w *= p1[4 * i + 1]; b1[4 * i] *= w;
        }
        u32x4 pa[4];
#pragma unroll
        for (int s = 0; s < 2; ++s) {
            pa[s] = (u32x4){pk2(b0[8 * s], b0[8 * s + 1]), pk2(b0[8 * s + 2], b0[8 * s + 3]), pk2(b0[8 * s + 4], b0[8 * s + 5]), pk2(b0[8 * s + 6], b0[8 * s + 7])};
            pa[2 + s] = (u32x4){pk2(b1[8 * s], b1[8 * s + 1]), pk2(b1[8 * s + 2], b1[8 * s + 3]), pk2(b1[8 * s + 4], b1[8 * s + 5]), pk2(b1[8 * s + 6], b1[8 * s + 7])};
        }
        SB_WAIT_V(8);
#pragma unroll
        for (int s = 0; s < 4; ++s) {
            const u32x2 l0 = *(const LAS u32x2*)(vr + (((2 * s) ^ swr) << 4)), h0 = *(const LAS u32x2*)(vr + (((2 * s + 1) ^ swr) << 4));
            const u32x2 l1 = *(const LAS u32x2*)(vr + 32 * 128 + (((2 * s) ^ swr) << 4)), h1 = *(const LAS u32x2*)(vr + 32 * 128 + (((2 * s + 1) ^ swr) << 4));
            const u32x4 v0 = {l0.x, l0.y, h0.x, h0.y}, v1 = {l1.x, l1.y, h1.x, h1.y};
            o0 = __builtin_amdgcn_mfma_f32_32x32x16_bf16(__builtin_bit_cast(bf16x8, pa[s]), __builtin_bit_cast(bf16x8, v0), o0, 0, 0, 0);
            o1 = __builtin_amdgcn_mfma_f32_32x32x16_bf16(__builtin_bit_cast(bf16x8, pa[s]), __builtin_bit_cast(bf16x8, v1), o1, 0, 0, 0);
        }
        asm volatile("s_waitcnt lgkmcnt(0)" ::: "memory");
        sb_dma_tile(Vg + jn * 64, M, vl, lane);
        if (__all(C < SB_STOP)) break;
    }
    SB_WAIT_V(0);
    f32x4 nw[8];
    { const float* wv = p.sb_w + h * 64 + (lane & 1) * 32;
#pragma unroll
      for (int j = 0; j < 8; ++j) nw[j] = *(const f32x4*)(wv + 4 * j); }
    LAS float* stg = (LAS float*)wl;
#pragma unroll
    for (int r = 0; r < 16; ++r) { const int row = (r & 3) + 8 * (r >> 2) + 4 * hi; stg[row * SB_STG_PITCH + r32] = o0[r]; stg[row * SB_STG_PITCH + 32 + r32] = o1[r]; }
    asm volatile("s_waitcnt lgkmcnt(0)" ::: "memory");
    {
        const int row = lane >> 1, half = lane & 1;
        f32x4 v[8]; float ss = 0.f;
#pragma unroll
        for (int j = 0; j < 8; ++j) { v[j] = *(const LAS f32x4*)(stg + row * SB_STG_PITCH + half * 32 + 4 * j); ss += v[j][0] * v[j][0] + v[j][1] * v[j][1] + v[j][2] * v[j][2] + v[j][3] * v[j][3]; }
        ss += __shfl_xor(ss, 1);
        const float rs = rsqrtf(ss * (1.0f / 64) + EPS);
        bf16* mo = p.mix() + (tok0 + q0 + row) * DM + h * 64 + half * 32;
#pragma unroll
        for (int j = 0; j < 4; ++j) *(u32x4*)(mo + 8 * j) = pack8(v[2 * j] * rs * nw[2 * j], v[2 * j + 1] * rs * nw[2 * j + 1]);
    }
    asm volatile("s_waitcnt lgkmcnt(0)" ::: "memory");
}
constexpr int SB_WAVES = 5;
__device__ __forceinline__ void ph_sb_conv(const P& p, LAS unsigned char* lds, int bid, int nb) {
    const int tid = phase_tid(), wid = __builtin_amdgcn_readfirstlane(tid >> 6);
    LAS unsigned char* wl = lds + wid * 16384;
    LAS int* qsb = (LAS int*)(lds + MISC_OFF + 64); LAS int* qcv = qsb + 1;
    int nx = 0; for (int x = bid; x < 256; x += nb) ++nx;
    const int ncv = (T_NITEMS - T_DENSE_ITEMS - bid + nb - 1) / nb;
#define SBC_PULL(q, dst) do { int v_ = 0; if ((threadIdx.x & 63) == 0) v_ = __hip_atomic_fetch_add(q, 1, __ATOMIC_RELAXED, __HIP_MEMORY_SCOPE_WORKGROUP); dst = __builtin_amdgcn_readfirstlane(v_); } while (0)
    int ph = 0; asm volatile("" : "+s"(ph));
    for (; ph < 2; ++ph) {
        if ((ph == 0) == (wid < SB_WAVES)) {
            const int lane = phase_tid() & 63;
            for (;;) {
                int u; SBC_PULL(qsb, u);
                if (u >= 32 * nx) break;
                const int x = bid + nb * (u >> 5), q = x & 7, c = (x >> 3) >> 2, g = (x >> 3) & 3, uu = u & 31;
                const int uq = 3 - (uu >> 3), grp = uq == 0 ? g : uq == 1 ? 7 - g : uq == 2 ? 8 + g : 15 - g;
                const int bb = (c + 2 * uq) & 7, hh = (q - bb) & 7;
                sb_unit(p, wl, bb, hh, grp * 8 + 7 - (uu & 7), lane);
            }
        } else {
            const int lane = phase_tid() & 63;
            LAS float* scr = (LAS float*)wl;
            f32x4 va[16], vb[16], sa[4], sb[4];
            int k; SBC_PULL(qcv, k);
            if (k < ncv) {
                TItem ta = t_decode(p, T_DENSE_ITEMS + bid + nb * k), tb = ta;
                t_load8(ta, va, sa, lane);
                __builtin_amdgcn_sched_barrier(0);
                for (;;) {
                    int k1; SBC_PULL(qcv, k1);
                    const bool h1 = k1 < ncv;
                    tb = t_decode(p, T_DENSE_ITEMS + bid + nb * (h1 ? k1 : k)); t_load8(tb, vb, sb, lane);
                    __builtin_amdgcn_sched_barrier(0);
                    t_store8(ta, va, sa, scr, lane);
                    if (!h1) break;
                    int k2; SBC_PULL(qcv, k2);
                    const bool h2 = k2 < ncv;
                    ta = t_decode(p, T_DENSE_ITEMS + bid + nb * (h2 ? k2 : k1)); t_load8(ta, va, sa, lane);
                    __builtin_amdgcn_sched_barrier(0);
                    t_store8(tb, vb, sb, scr, lane);
                    if (!h2) break;
                    k = k2;
                }
                asm volatile("s_waitcnt vmcnt(0)" ::: "memory");
            }
        }
    }
#undef SBC_PULL
}
#undef SB_WAIT_V

constexpr int HG_TOT = 0, HG_KUT = 4096, HG_KUT_PITCH = 144, HG_UST = 24576;
constexpr int HG_PITCH = 272, HG_QH = 4096, HG_QI = HG_QH + 64 * HG_PITCH, HG_KH = HG_QI + 64 * HG_PITCH, HG_OST = HG_KH + 64 * HG_PITCH, HG_OST_PITCH = 132;
__device__ __forceinline__ void hg_cumsum(const unsigned (&g)[8], LAS unsigned char* lds, int ch2, int oct, float (&bc0)[8], float (&bc1)[8], float& bl0, float& bl1, float& br0, float& br1) {
    float a0 = 0.f, a1 = 0.f;
#pragma unroll
    for (int i = 0; i < 8; ++i) { typedef _Float16 f16x2 __attribute__((ext_vector_type(2))); const f16x2 kh = __builtin_bit_cast(f16x2, g[i]); a0 += __logf(fmaxf(1.0f - (float)kh.x, 1.0f / 4096)); a1 += __logf(fmaxf(1.0f - (float)kh.y, 1.0f / 4096));     bc0[i] = a0; bc1[i] = a1; }
    LAS float* TOT = (LAS float*)(lds + HG_TOT);
    *(LAS f32x2*)(TOT + oct * 128 + ch2) = (f32x2){a0, a1};
    __syncthreads();
    float of0 = 0.f, of1 = 0.f; bl0 = 0.f; bl1 = 0.f; br0 = 0.f; br1 = 0.f;
#pragma unroll
    for (int o = 0; o < 8; ++o) {
        const f32x2 tv = *(const LAS f32x2*)(TOT + o * 128 + ch2);
        if (o < oct) { of0 += tv.x; of1 += tv.y; }
        if (o < 4) { br0 += tv.x; br1 += tv.y; }
        bl0 += tv.x; bl1 += tv.y;
    }
#pragma unroll
    for (int i = 0; i < 8; ++i) { bc0[i] += of0; bc1[i] += of1; }
}
__device__ __forceinline__ float fexp(float x) { return __builtin_amdgcn_exp2f(1.4426950408889634f * x); }
__device__ __forceinline__ float f16lo(unsigned w) { typedef _Float16 f16x2 __attribute__((ext_vector_type(2))); return (float)__builtin_bit_cast(f16x2, w).x; }
__device__ __forceinline__ float f16hi(unsigned w) { typedef _Float16 f16x2 __attribute__((ext_vector_type(2))); return (float)__builtin_bit_cast(f16x2, w).y; }

__device__ __forceinline__ void ph_hg_state(const P& p, LAS unsigned char* lds, int bid, int nb) {
    const int tid = phase_tid(), wid = __builtin_amdgcn_readfirstlane(tid >> 6), lane = tid & 63, r32 = lane & 31, hi = lane >> 5;
    const int ch2 = lane * 2, oct = wid, vt = wid >> 1;
    bf16* U = (bf16*)p.out;
    constexpr int NU = BATCH * HGH * 64;
    unsigned g[8]; bf16x8 af[4];
#define HGS_TOK0(un) ((size_t)(((un) >> 6) >> 2) * SEQ + ((un) & 63) * 64)
#define HGS_LOAD_A(un) do { const size_t t0_ = HGS_TOK0(un); const int h_ = ((un) >> 6) & 3; const _Float16* lf = p.hkf() + t0_ * 512 + h_ * 128; \
        _Pragma("unroll") for (int i = 0; i < 8; ++i) g[i] = *(const unsigned*)(lf + (size_t)(oct * 8 + i) * 512 + ch2); } while (0)
#define HGS_LOAD_B(un) do { const size_t t0_ = HGS_TOK0(un); const int h_ = ((un) >> 6) & 3; const bf16* A = p.vt() + (size_t)(512 + h_ * 128 + vt * 32 + r32) * M + t0_ + hi * 8; \
        _Pragma("unroll") for (int ks = 0; ks < 4; ++ks) af[ks] = *(const bf16x8*)(A + ks * 16); } while (0)
    { const int u0 = bid < NU ? bid : 0; HGS_LOAD_A(u0); __builtin_amdgcn_sched_barrier(0); HGS_LOAD_B(u0); __builtin_amdgcn_sched_barrier(0); }
    for (int unit = bid; unit < NU; unit += nb) {
        const int nxt = unit + nb < NU ? unit + nb : unit;
        float bc0[8], bc1[8], bl0, bl1, br0, br1;
        hg_cumsum(g, lds, ch2, oct, bc0, bc1, bl0, bl1, br0, br1);
        float u0[8], u1[8];
#pragma unroll
        for (int i = 0; i < 8; ++i) { u0[i] = f16lo(g[i]) * fexp(bl0 - bc0[i]); u1[i] = f16hi(g[i]) * fexp(bl1 - bc1[i]); }
        *(LAS u32x4*)(lds + HG_KUT + ch2 * HG_KUT_PITCH + oct * 16) = (u32x4){pk2(u0[0], u0[1]), pk2(u0[2], u0[3]), pk2(u0[4], u0[5]), pk2(u0[6], u0[7])};
        *(LAS u32x4*)(lds + HG_KUT + (ch2 + 1) * HG_KUT_PITCH + oct * 16) = (u32x4){pk2(u1[0], u1[1]), pk2(u1[2], u1[3]), pk2(u1[4], u1[5]), pk2(u1[6], u1[7])};
        if (oct == 0) *(f32x2*)(p.hgd() + (size_t)unit * 128 + ch2) = (f32x2){fexp(bl0), fexp(bl1)};
        __syncthreads();
        HGS_LOAD_A(nxt);
        f32x16 acc[2];
#pragma unroll
        for (int cl = 0; cl < 2; ++cl) {
            const int ct = (wid & 1) * 2 + cl;
#pragma unroll
            for (int r = 0; r < 16; ++r) acc[cl][r] = 0.f;
#pragma unroll
            for (int ks = 0; ks < 4; ++ks) {
                const bf16x8 bf = *(const LAS bf16x8*)(lds + HG_KUT + (ct * 32 + r32) * HG_KUT_PITCH + (ks * 16 + hi * 8) * 2);
                acc[cl] = __builtin_amdgcn_mfma_f32_32x32x16_bf16(af[ks], bf, acc[cl], 0, 0, 0);
            }
        }
        HGS_LOAD_B(nxt);
        { LAS float* st = (LAS float*)(lds + HG_UST + wid * SB_STG_BYTES);
#pragma unroll
          for (int cl = 0; cl < 2; ++cl)
#pragma unroll
              for (int r = 0; r < 16; ++r) st[((r & 3) + 8 * (r >> 2) + 4 * hi) * SB_STG_PITCH + cl * 32 + r32] = acc[cl][r];
          asm volatile("s_waitcnt lgkmcnt(0)" ::: "memory");
          const int row = lane >> 1, half = lane & 1;
          bf16* Uo = U + (size_t)unit * 16384 + (size_t)(vt * 32 + row) * 128 + (wid & 1) * 64 + half * 32;
#pragma unroll
          for (int j = 0; j < 4; ++j) {
              const f32x4 a = *(const LAS f32x4*)(st + row * SB_STG_PITCH + half * 32 + 8 * j), c2 = *(const LAS f32x4*)(st + row * SB_STG_PITCH + half * 32 + 8 * j + 4);
              *(u32x4*)(Uo + 8 * j) = pack8(a, c2);
          }
          asm volatile("s_waitcnt lgkmcnt(0)" ::: "memory"); }
    }
#undef HGS_LOAD_A
#undef HGS_LOAD_B
    __syncthreads();
}
__device__ __forceinline__ void ph_hg_scan(const P& p, int bid, int nb) {
    const bf16* U = (const bf16*)p.out;
    for (int e = bid * NT + threadIdx.x; e < BATCH * HGH * 4096; e += nb * NT) {
        const int bh = e >> 12, v = (e >> 5) & 127, c4 = (e & 31) * 4;
        f32x4 S = {0.f, 0.f, 0.f, 0.f};
        const size_t o0 = (size_t)bh * 64 * 16384 + (size_t)v * 128 + c4;
        const float* dp = p.hgd() + (size_t)(bh * 64) * 128 + c4;
#pragma unroll 1
        for (int c0 = 0; c0 < 64; c0 += 8) {
            u32x2 uw[8]; f32x4 d[8];
#pragma unroll
            for (int j = 0; j < 8; ++j) { uw[j] = __builtin_nontemporal_load((const u32x2*)(U + o0 + (size_t)(c0 + j) * 16384)); d[j] = *(const f32x4*)(dp + (size_t)(c0 + j) * 128); }
#pragma unroll
            for (int j = 0; j < 8; ++j) {
                const f32x4 u = {bflo(uw[j].x), bfhi(uw[j].x), bflo(uw[j].y), bfhi(uw[j].y)};
                u32x2 w; w.x = pk2(S[0], S[1]); w.y = pk2(S[2], S[3]);
                *(u32x2*)(p.sprev() + o0 + (size_t)(c0 + j) * 16384) = w;
                S = d[j] * S + u;
            }
        }
    }
}
__device__ __forceinline__ void ph_hg_out(const P& p, LAS unsigned char* lds, int bid, int nb) {
    const int tid = phase_tid(), wid = __builtin_amdgcn_readfirstlane(tid >> 6), lane = tid & 63, r32 = lane & 31, hi = lane >> 5;
    const int ch2 = lane * 2, oct = wid;
    const int tb = wid >> 2, vb = wid & 3;
    const int tn = tid >> 3, sg = tid & 7;
    constexpr int NU = BATCH * HGH * 64;
    unsigned g[8], qq[8]; bf16x8 bS[8]; u32x2 vl[2][2], vh[2][2]; u32x4 g0, g1; f32x4 w0, w1, w2, w3;
#define HGO_LOAD_A(un) do { const size_t t0_ = HGS_TOK0(un); const int h_ = ((un) >> 6) & 3; const _Float16* lf = p.hkf() + t0_ * 512 + h_ * 128; \
        _Pragma("unroll") for (int i = 0; i < 8; ++i) g[i] = *(const unsigned*)(lf + (size_t)(oct * 8 + i) * 512 + ch2); \
        _Pragma("unroll") for (int i = 0; i < 8; ++i) { const size_t gi = (t0_ + oct * 8 + i) * 512 + h_ * 128 + ch2; qq[i] = *(const unsigned*)(p.hq() + gi); } } while (0)
#define HGO_LOAD_B(un) do { const size_t t0_ = HGS_TOK0(un); const int h_ = ((un) >> 6) & 3; \
        const bf16* Sp = p.sprev() + (size_t)(un) * 16384 + (size_t)(vb * 32 + r32) * 128 + hi * 8; \
        _Pragma("unroll") for (int ks = 0; ks < 8; ++ks) bS[ks] = *(const bf16x8*)(Sp + ks * 16); \
        const bf16* Vt = p.vt() + (size_t)(512 + h_ * 128 + vb * 32 + r32) * M + t0_ + hi * 4; \
        _Pragma("unroll") for (int sb = 0; sb < 2; ++sb) _Pragma("unroll") for (int k2 = 0; k2 < 2; ++k2) { vl[sb][k2] = *(const u32x2*)(Vt + sb * 32 + 16 * k2); vh[sb][k2] = *(const u32x2*)(Vt + sb * 32 + 16 * k2 + 8); } \
        const bf16* gp = p.hgate() + (t0_ + tn) * 512 + h_ * 128 + sg * 16; g0 = *(const u32x4*)(gp); g1 = *(const u32x4*)(gp + 8); \
        const float* wv_ = p.hg_w + h_ * 128 + sg * 16; w0 = *(const f32x4*)(wv_); w1 = *(const f32x4*)(wv_ + 4); w2 = *(const f32x4*)(wv_ + 8); w3 = *(const f32x4*)(wv_ + 12); } while (0)
    { const int u0 = bid < NU ? bid : 0; HGO_LOAD_A(u0); __builtin_amdgcn_sched_barrier(0); HGO_LOAD_B(u0); __builtin_amdgcn_sched_barrier(0); }
    for (int unit = bid; unit < NU; unit += nb) {
        const int nxt = unit + nb < NU ? unit + nb : unit;
        const int h = (unit >> 6) & 3;
        const size_t tok0 = HGS_TOK0(unit);
        float bc0[8], bc1[8], bl0, bl1, br0, br1;
        hg_cumsum(g, lds, ch2, oct, bc0, bc1, bl0, bl1, br0, br1);
#pragma unroll
        for (int i = 0; i < 8; ++i) {
            const int lo = (oct * 8 + i) * HG_PITCH + ch2 * 2;
            *(LAS unsigned*)(lds + HG_QH + lo) = pk2(bflo(qq[i]) * fexp(fminf(bc0[i] - br0, 80.f)), bfhi(qq[i]) * fexp(fminf(bc1[i] - br1, 80.f)));
            *(LAS unsigned*)(lds + HG_QI + lo) = pk2(bflo(qq[i]) * fexp(bc0[i]), bfhi(qq[i]) * fexp(bc1[i]));
            *(LAS unsigned*)(lds + HG_KH + lo) = pk2(f16lo(g[i]) * fexp(fminf(br0 - bc0[i], 80.f)), f16hi(g[i]) * fexp(fminf(br1 - bc1[i], 80.f)));
        }
        __syncthreads();
        HGO_LOAD_A(nxt);
        f32x16 o;
#pragma unroll
        for (int r = 0; r < 16; ++r) o[r] = 0.f;
#pragma unroll
        for (int ks = 0; ks < 8; ++ks) {
            const bf16x8 a = *(const LAS bf16x8*)(lds + HG_QI + (tb * 32 + r32) * HG_PITCH + (ks * 16 + hi * 8) * 2);
            o = __builtin_amdgcn_mfma_f32_32x32x16_bf16(a, bS[ks], o, 0, 0, 0);
        }
#pragma unroll
        for (int sb = 0; sb < 2; ++sb) {
            if (sb <= tb) {
                f32x16 x;
#pragma unroll
                for (int r = 0; r < 16; ++r) x[r] = 0.f;
#pragma unroll
                for (int ks = 0; ks < 8; ++ks) {
                    const bf16x8 a = *(const LAS bf16x8*)(lds + HG_KH + (sb * 32 + r32) * HG_PITCH + (ks * 16 + hi * 8) * 2);
                    const bf16x8 bq = *(const LAS bf16x8*)(lds + HG_QH + (tb * 32 + r32) * HG_PITCH + (ks * 16 + hi * 8) * 2);
                    x = __builtin_amdgcn_mfma_f32_32x32x16_bf16(a, bq, x, 0, 0, 0);
                }
                if (sb == tb) {
#pragma unroll
                    for (int r = 0; r < 16; ++r) { const int sl = (r & 3) + 8 * (r >> 2) + 4 * hi; x[r] = sl <= r32 ? x[r] : 0.f; }
                }
#pragma unroll
                for (int k2 = 0; k2 < 2; ++k2) {
                    const u32x4 pa = {pk2(x[8 * k2], x[8 * k2 + 1]), pk2(x[8 * k2 + 2], x[8 * k2 + 3]), pk2(x[8 * k2 + 4], x[8 * k2 + 5]), pk2(x[8 * k2 + 6], x[8 * k2 + 7])};
                    const u32x4 vv = {vl[sb][k2].x, vl[sb][k2].y, vh[sb][k2].x, vh[sb][k2].y};
                    o = __builtin_amdgcn_mfma_f32_32x32x16_bf16(__builtin_bit_cast(bf16x8, pa), __builtin_bit_cast(bf16x8, vv), o, 0, 0, 0);
                }
            }
        }
        { LAS float* OST = (LAS float*)(lds + HG_OST);
#pragma unroll
          for (int r = 0; r < 16; ++r) OST[(tb * 32 + (r & 3) + 8 * (r >> 2) + 4 * hi) * HG_OST_PITCH + vb * 32 + r32] = o[r]; }
        __syncthreads();
        {
            const LAS float* orow = (const LAS float*)(lds + HG_OST) + tn * HG_OST_PITCH + sg * 16;
            f32x4 v[4]; float ss = 0.f;
#pragma unroll
            for (int j = 0; j < 4; ++j) { v[j] = *(const LAS f32x4*)(orow + 4 * j); ss += v[j][0] * v[j][0] + v[j][1] * v[j][1] + v[j][2] * v[j][2] + v[j][3] * v[j][3]; }
            ss += __shfl_xor(ss, 1); ss += __shfl_xor(ss, 2); ss += __shfl_xor(ss, 4);
            const float rs = rsqrtf(ss * (1.0f / 128) + EPS);
            const int col = h * 128 + sg * 16;
            const f32x4 ga = {bflo(g0.x), bfhi(g0.x), bflo(g0.y), bfhi(g0.y)}, gb = {bflo(g0.z), bfhi(g0.z), bflo(g0.w), bfhi(g0.w)};
            const f32x4 gc = {bflo(g1.x), bfhi(g1.x), bflo(g1.y), bfhi(g1.y)}, gd = {bflo(g1.z), bfhi(g1.z), bflo(g1.w), bfhi(g1.w)};
            const u32x4 r0 = pack8(v[0] * rs * w0 * ga, v[1] * rs * w1 * gb), r1 = pack8(v[2] * rs * w2 * gc, v[3] * rs * w3 * gd);
            HGO_LOAD_B(nxt);
            bf16* mo = p.mix() + (tok0 + tn) * DM + 512 + col;
            *(u32x4*)(mo) = r0; *(u32x4*)(mo + 8) = r1;
        }
    }
#undef HGO_LOAD_A
#undef HGO_LOAD_B
#undef HGS_TOK0
    __syncthreads();
}

__device__ __forceinline__ void ph_route(const P& p, LAS unsigned char* lds, int bid, int nb) {
    const int tid = phase_tid(), wid = __builtin_amdgcn_readfirstlane(tid >> 6), lane = tid & 63, r32 = lane & 31, hi = lane >> 5;
    LAS int* wcnt = (LAS int*)lds; LAS int* wbase = wcnt + 4 * 32;
    constexpr int RT_WL = 1024, RT_PITCH = 2080, RT_ROWS = 36, RT_XCH = RT_WL + RT_ROWS * RT_PITCH;
    for (int id = tid; id < RT_ROWS * 128; id += NT) {
        const int row = id >> 7, c = id & 127, tau = row >> 4, j = row & 15, rho = (j & 3) + 8 * (j >> 2);
        *(LAS u32x4*)(lds + RT_WL + row * RT_PITCH + c * 16) = *(const u32x4*)(p.wrt() + (size_t)(tau * 32 + rho) * DM + c * 8);
    }
    __syncthreads();
    for (int bu = bid; bu < M / 128; bu += nb) {
        int m = 0, ex1 = -1, ex2 = -2, off1 = 0, off2 = 0, cnt_mine = 0; float rs = 0.f, g1 = 0.f, g2 = 0.f;
        const int wq = wid & 3, kh = wid >> 2;
        m = (bu * 4 + wq) * 32 + r32;
        f32x16 a0, a1, a2; float ss = 0.f;
        {
            const bf16* Bp = p.h1b() + (size_t)m * DM + kh * 512 + hi * 8;
            const int jr = (r32 & 3) + 4 * (r32 >> 3);
            const LAS unsigned char* Al = lds + RT_WL + jr * RT_PITCH + kh * 1024 + hi * 16;
            const LAS unsigned char* Al2 = lds + RT_WL + (32 + (jr & 3)) * RT_PITCH + kh * 1024 + hi * 16;
#pragma unroll
            for (int r = 0; r < 16; ++r) { a0[r] = 0.f; a1[r] = 0.f; a2[r] = 0.f; }
#pragma unroll
            for (int kb = 0; kb < 2; ++kb) {
                u32x4 bw[16];
#pragma unroll
                for (int j = 0; j < 16; ++j) bw[j] = *(const u32x4*)(Bp + (kb * 16 + j) * 16);
#pragma unroll
                for (int j = 0; j < 16; ++j) {
                    const int ks = kb * 16 + j; const u32x4 w_ = bw[j];
                    ss += bflo(w_.x) * bflo(w_.x) + bfhi(w_.x) * bfhi(w_.x) + bflo(w_.y) * bflo(w_.y) + bfhi(w_.y) * bfhi(w_.y) + bflo(w_.z) * bflo(w_.z) + bfhi(w_.z) * bfhi(w_.z) + bflo(w_.w) * bflo(w_.w) + bfhi(w_.w) * bfhi(w_.w);
                    const bf16x8 b = __builtin_bit_cast(bf16x8, w_);
                    a0 = __builtin_amdgcn_mfma_f32_32x32x16_bf16(*(const LAS bf16x8*)(Al + ks * 32), b, a0, 0, 0, 0);
                    a1 = __builtin_amdgcn_mfma_f32_32x32x16_bf16(*(const LAS bf16x8*)(Al + 16 * RT_PITCH + ks * 32), b, a1, 0, 0, 0);
                    a2 = __builtin_amdgcn_mfma_f32_32x32x16_bf16(*(const LAS bf16x8*)(Al2 + ks * 32), b, a2, 0, 0, 0);
                }
            }
            LAS float* xch = (LAS float*)(lds + RT_XCH) + wq * (49 * 64) + lane;
            if (kh == 1) {
#pragma unroll
                for (int r = 0; r < 16; ++r) { xch[r * 64] = a0[r]; xch[(16 + r) * 64] = a1[r]; xch[(32 + r) * 64] = a2[r]; }
                xch[48 * 64] = ss;
            }
            __syncthreads();
            if (kh == 0) {
#pragma unroll
                for (int r = 0; r < 16; ++r) { a0[r] += xch[r * 64]; a1[r] += xch[(16 + r) * 64]; a2[r] += xch[(32 + r) * 64]; }
                ss += xch[48 * 64];
            }
        }
        if (wid < 4) {
            ss += partner32(ss, hi);
            rs = rsqrtf(ss * (1.0f / DM) + EPS);
            float gl[4];
    #pragma unroll
            for (int g = 0; g < 4; ++g) gl[g] = a0[g] * rs + p.bgr[g];
            int gi = 0; float best = gl[0];
    #pragma unroll
            for (int g = 1; g < 4; ++g) if (gl[g] > best) { best = gl[g]; gi = g; }
            float den = 0.f;
    #pragma unroll
            for (int g = 0; g < 4; ++g) den += expf(gl[g] - best);
            const float gprob = 1.0f / den;
            float ig[8], bsel[8];
    #pragma unroll
            for (int e = 0; e < 8; ++e) bsel[e] = p.ber[gi * 8 + e];
    #pragma unroll
            for (int e = 0; e < 8; ++e) {
                const float c0 = a0[4 + e];
                const float c1 = (e < 4 ? a0[(12 + e) & 15] : a1[(e - 4) & 15]);
                const float c2 = a1[4 + e];
                const float c3 = (e < 4 ? a1[(12 + e) & 15] : a2[(e - 4) & 15]);
                ig[e] = (gi == 0 ? c0 : gi == 1 ? c1 : gi == 2 ? c2 : c3) * rs + bsel[e];
            }
            int i1 = 0; float v1 = ig[0];
    #pragma unroll
            for (int e = 1; e < 8; ++e) if (ig[e] > v1) { v1 = ig[e]; i1 = e; }
            int i2 = -1; float v2 = -INFINITY;
    #pragma unroll
            for (int e = 0; e < 8; ++e) if (e != i1 && ig[e] > v2) { v2 = ig[e]; i2 = e; }
            const float e2 = expf(v2 - v1); g1 = gprob / (1.0f + e2); g2 = gprob * e2 / (1.0f + e2);
            ex1 = hi ? -1 : gi * 8 + i1; ex2 = hi ? -2 : gi * 8 + i2;
            cnt_mine = 0; off1 = 0; off2 = 0;
            const unsigned long long below = (1ull << lane) - 1ull;
    #pragma unroll 4
            for (int e = 0; e < NE; ++e) {
                const unsigned long long m1 = __ballot(ex1 == e), m2 = __ballot(ex2 == e);
                const int c1n = __popcll(m1), c2n = __popcll(m2);
                if (lane == e) cnt_mine = c1n + c2n;
                if (ex1 == e) off1 = __popcll(m1 & below);
                if (ex2 == e) off2 = c1n + __popcll(m2 & below);
            }
            if (lane < NE) wcnt[wid * 32 + lane] = cnt_mine;
        }
        __syncthreads();
        if (wid == 0 && lane < NE) {
            const int c0 = wcnt[lane], c1 = wcnt[32 + lane], c2 = wcnt[64 + lane], c3 = wcnt[96 + lane], tot = c0 + c1 + c2 + c3;
            const int base = tot > 0 ? (int)atomicAdd(&p.ctl()[CW_CNT + lane * CNT_STRIDE], (unsigned)tot) : 0;
            wbase[lane] = base; wbase[32 + lane] = base + c0; wbase[64 + lane] = base + c0 + c1; wbase[96 + lane] = base + c0 + c1 + c2;
        }
        __syncthreads();
        if (wid < 4 && hi == 0) {
            const int b1 = wbase[wid * 32 + ex1], b2 = wbase[wid * 32 + ex2];
            p.toke()[2 * m] = ex1; p.toke()[2 * m + 1] = ex2; p.tokr()[2 * m] = b1 + off1; p.tokr()[2 * m + 1] = b2 + off2;
            p.gate()[2 * m] = g1; p.gate()[2 * m + 1] = g2; p.rstd1()[m] = rs;
            p.list()[ex1 * M + b1 + off1] = m; p.list()[ex2 * M + b2 + off2] = m;
        }
        __syncthreads();
    }
}

__device__ void ph_combine(const P& p, const MoeTab* T, int bid, int nb) {
    const int tid = phase_tid(), wave = tid >> 6, lane = tid & 63, st = nb * 8;
    typedef float f32x2v __attribute__((ext_vector_type(2)));
    const int mw = bid * 8 + wave;
    if (mw >= M) return;
    struct Ix { u32x2 e, r; f32x2v g; };
    struct Dt { u32x4 h[2]; u32x2 a[2], b[2]; f32x2v g; };
#define CB_IDX(I, mm) { const int m_ = (mm) < M ? (mm) : mw; I.e = *(const u32x2*)(p.toke() + 2 * m_); I.r = *(const u32x2*)(p.tokr() + 2 * m_); I.g = *(const f32x2v*)(p.gate() + 2 * m_); }
#define CB_DATA(D, I, mm) { const int m_ = (mm) < M ? (mm) : mw; const size_t p0 = (size_t)(T->off[I.e.x] + (int)I.r.x), p1 = (size_t)(T->off[I.e.y] + (int)I.r.y); D.g = I.g; \
        const u32x4* hr = (const u32x4*)(p.h1b() + (size_t)m_ * DM); const u32x2* y0 = (const u32x2*)(p.y8() + p0 * DM); const u32x2* y1 = (const u32x2*)(p.y8() + p1 * DM); \
        _Pragma("unroll") for (int j = 0; j < 2; ++j) { D.h[j] = __builtin_nontemporal_load(&hr[lane + 64 * j]); D.a[j] = __builtin_nontemporal_load(&y0[lane + 64 * j]); D.b[j] = __builtin_nontemporal_load(&y1[lane + 64 * j]); } }
#define CB_BODY(D, mm) if ((mm) < M) { const float g0 = D.g.x * (1.0f / FP8_SY), g1 = D.g.y * (1.0f / FP8_SY); u32x4* ho = (u32x4*)(p.h2b() + (size_t)(mm) * DM); float ss = 0.f; \
        _Pragma("unroll") for (int j = 0; j < 2; ++j) { \
            const f32x2v a0 = __builtin_amdgcn_cvt_pk_f32_fp8(D.a[j].x, false), a1 = __builtin_amdgcn_cvt_pk_f32_fp8(D.a[j].x, true), a2 = __builtin_amdgcn_cvt_pk_f32_fp8(D.a[j].y, false), a3 = __builtin_amdgcn_cvt_pk_f32_fp8(D.a[j].y, true); \
            const f32x2v b0 = __builtin_amdgcn_cvt_pk_f32_fp8(D.b[j].x, false), b1 = __builtin_amdgcn_cvt_pk_f32_fp8(D.b[j].x, true), b2 = __builtin_amdgcn_cvt_pk_f32_fp8(D.b[j].y, false), b3 = __builtin_amdgcn_cvt_pk_f32_fp8(D.b[j].y, true); \
            f32x4 v0, v1; \
            v0[0] = bflo(D.h[j].x) + (g0 * a0[0] + g1 * b0[0]); v0[1] = bfhi(D.h[j].x) + (g0 * a0[1] + g1 * b0[1]); \
            v0[2] = bflo(D.h[j].y) + (g0 * a1[0] + g1 * b1[0]); v0[3] = bfhi(D.h[j].y) + (g0 * a1[1] + g1 * b1[1]); \
            v1[0] = bflo(D.h[j].z) + (g0 * a2[0] + g1 * b2[0]); v1[1] = bfhi(D.h[j].z) + (g0 * a2[1] + g1 * b2[1]); \
            v1[2] = bflo(D.h[j].w) + (g0 * a3[0] + g1 * b3[0]); v1[3] = bfhi(D.h[j].w) + (g0 * a3[1] + g1 * b3[1]); \
            ss += v0[0] * v0[0] + v0[1] * v0[1] + v0[2] * v0[2] + v0[3] * v0[3] + v1[0] * v1[0] + v1[1] * v1[1] + v1[2] * v1[2] + v1[3] * v1[3]; \
            ho[lane + 64 * j] = pack8(v0, v1); \
            { const f32x4 q0_ = v0 * FP8_SH, q1_ = v1 * FP8_SH; *(u32x2*)(p.h2q() + (size_t)(mm) * DM + (lane + 64 * j) * 8) = (u32x2){pk4_fp8(q0_[0], q0_[1], q0_[2], q0_[3]), pk4_fp8(q1_[0], q1_[1], q1_[2], q1_[3])}; } } \
        ss = wave_sum(ss); if (lane == 0) p.rstd2()[mm] = rsqrtf(ss * (1.0f / DM) + EPS); }
    Ix i0, i1; Dt d0, d1;
    CB_IDX(i0, mw)
    CB_IDX(i1, mw + st)
    __builtin_amdgcn_sched_barrier(0);
    CB_DATA(d0, i0, mw)
    __builtin_amdgcn_sched_barrier(0);
    for (int m = mw; m < M; m += 2 * st) {
        CB_IDX(i0, m + 2 * st)
        __builtin_amdgcn_sched_barrier(0);
        CB_DATA(d1, i1, m + st)
        __builtin_amdgcn_sched_barrier(0);
        CB_BODY(d0, m)
        CB_IDX(i1, m + 3 * st)
        __builtin_amdgcn_sched_barrier(0);
        CB_DATA(d0, i0, m + 2 * st)
        __builtin_amdgcn_sched_barrier(0);
        CB_BODY(d1, m + st)
    }
#undef CB_IDX
#undef CB_DATA
#undef CB_BODY
}
__device__ void ph_final(const P& p, int bid, int nb) {
    const int tid = phase_tid(), wave = tid >> 6, lane = tid & 63;
    for (int m = bid * 8 + wave; m < M; m += nb * 8) {
        const u32x4* hr = (const u32x4*)(p.h3b() + (size_t)m * DM);
        f32x4 v[4]; float ss = 0.f;
#pragma unroll
        for (int j = 0; j < 2; ++j) {
            const u32x4 h = __builtin_nontemporal_load(&hr[lane + 64 * j]);
            v[2 * j] = (f32x4){bflo(h.x), bfhi(h.x), bflo(h.y), bfhi(h.y)}; v[2 * j + 1] = (f32x4){bflo(h.z), bfhi(h.z), bflo(h.w), bfhi(h.w)};
        }
#pragma unroll
        for (int j = 0; j < 4; ++j) ss += v[j][0] * v[j][0] + v[j][1] * v[j][1] + v[j][2] * v[j][2] + v[j][3] * v[j][3];
        ss = wave_sum(ss);
        const float r = rsqrtf(ss * (1.0f / DM) + EPS);
        f32x4* orow = (f32x4*)(p.out + (size_t)m * DM);
#pragma unroll
        for (int j = 0; j < 2; ++j) {
            const f32x4 w0 = *(const f32x4*)(p.fin_w + (lane + 64 * j) * 8), w1 = *(const f32x4*)(p.fin_w + (lane + 64 * j) * 8 + 4);
            __builtin_nontemporal_store(v[2 * j] * r * w0, &orow[(lane + 64 * j) * 2]); __builtin_nontemporal_store(v[2 * j + 1] * r * w1, &orow[(lane + 64 * j) * 2 + 1]);
        }
    }
}

constexpr int CW_BAR = 4096;
constexpr size_t CTL_ZERO_BYTES = 64 * 1024;

__global__ void __launch_bounds__(NT, 2) fwd_megakernel(P p) {
    extern __shared__ __attribute__((aligned(16))) unsigned char lds_raw[];
    LAS unsigned char* lds3 = (LAS unsigned char*)lds_raw;
    volatile LAS unsigned* MISC = (volatile LAS unsigned*)(lds3 + MISC_OFF);
    MoeTab* T = (MoeTab*)(lds_raw + TAB_OFF);
    if (threadIdx.x < 32) MISC[threadIdx.x] = 0u;
    __syncthreads();
    XcdBarrier bar = xcd_barrier_post(p.ctl() + CW_BAR, MISC + 8);
    const int bid = blockIdx.x, nb = gridDim.x;
    ph_prep_weights<false>(p, lds3, bid, nb, 0, T_DENSE_ITEMS, PREP_ROW_WAVES, 8 - PREP_ROW_WAVES);
    ph_prep_router(p, bid, nb);
    ph_prep_rows(p, bid, nb);
    xcd_barrier(bar);
    { pg8::DenseOrder S; S.init(p.xn(), p.win(), M, INC - 1024, DM, nb, bid, 4); EpiInProj E{p}; pg8::gemm_phase(lds3, DM, S, E); }
    { pg8::DenseOrder S; S.init(p.win() + (size_t)(INC - 1024) * DM, p.xn(), 1024, M, DM, nb, bid, 4); EpiVT E{p}; pg8::gemm_phase(lds3, DM, S, E); }
    xcd_barrier(bar);
    ph_hg_state(p, lds3, bid, nb);
    ph_sb_conv(p, lds3, bid, nb);
    xcd_barrier(bar);
    ph_hg_scan(p, bid, nb);
    xcd_barrier(bar);
    ph_hg_out(p, lds3, bid, nb);
    xcd_barrier(bar);
    { pg8::DenseOrder S; S.init(p.mix(), p.wout(), M, DM, DM, nb, bid); EpiOutProj E{p}; pg8::gemm_phase(lds3, DM, S, E); }
    xcd_barrier(bar);
    ph_route(p, lds3, bid, nb);
    xcd_barrier(bar);
    moe_tab(p, T);
    moe_fill_tables(p, T, lds3, bid, nb);
    { MoeOrder S{(const LAS int*)(lds3 + UDESC_OFF), (const char*)p.h1q(), (const char*)p.wgu8(), (size_t)DM, (size_t)DM * DM, (size_t)256 * DM}; EpiMoeUp E{p, (const LAS float*)(lds3 + GTAB_OFF + GTAB_UNITS * 1024)};
      int k8 = DM / 2; asm volatile("" : "+s"(k8));
      pg8::gemm_phase<true, true>(lds3, k8, S, E, (const char*)p.h1q(), (const LAS int*)(lds3 + GTAB_OFF)); }
    xcd_barrier(bar);
    { MoeOrder S{(const LAS int*)(lds3 + UDESC_OFF), (const char*)p.act8(), (const char*)p.wd8(), (size_t)DE, (size_t)DM * DE, (size_t)256 * DE}; EpiMoeDown E{p}; int k8 = DE / 2; asm volatile("" : "+s"(k8)); pg8::gemm_phase<false, true>(lds3, k8, S, E); }
    xcd_barrier(bar);
    ph_combine(p, T, bid, nb);
    xcd_barrier(bar);
    { int kple = PLE; asm volatile("" : "+s"(kple)); pg8::DenseOrder S; S.init(p.pb(), p.wpp_t(), M, DM, kple, nb, bid, 4); EpiPleE E{p}; pg8::gemm_phase(lds3, kple, S, E); }
    { int k8 = DM / 2; asm volatile("" : "+s"(k8)); pg8::DenseOrder S; S.init(p.h2q(), p.wpg8(), M, DM, k8, nb, bid, 4); EpiPleGate E{p}; pg8::gemm_phase<false, true>(lds3, k8, S, E); }
    xcd_barrier(bar);
    ph_final(p, bid, nb);
}

extern "C" void kernel_launch(void* const* d_in, const int* in_sizes, int n_in, void* d_out, int out_size, void* d_ws, size_t ws_size, hipStream_t stream) {
    if (n_in != 20 || out_size != M * DM || ws_size < WS_END) { fprintf(stderr, "kernel_launch: unexpected shapes (n_in %d, out %d, ws %zu)\n", n_in, out_size, ws_size); return; }
    P p{};
    const float** f = (const float**)&p;
    for (int i = 0; i < 20; ++i) f[i] = (const float*)d_in[i];
    unsigned char* ws = (unsigned char*)d_ws;
    p.out = (float*)d_out; p.ws = ws;
    static int grid = 0;
    if (grid == 0) {
        int dev = 0, cus = 0, per_cu = 0;
        if (hipGetDevice(&dev) != hipSuccess || hipDeviceGetAttribute(&cus, hipDeviceAttributeMultiprocessorCount, dev) != hipSuccess) { fprintf(stderr, "kernel_launch: device query failed\n"); grid = -1; return; }
        if (hipFuncSetAttribute((const void*)fwd_megakernel, hipFuncAttributeMaxDynamicSharedMemorySize, LDS_BYTES) != hipSuccess) { fprintf(stderr, "kernel_launch: hipFuncSetAttribute failed\n"); grid = -1; return; }
        if (hipOccupancyMaxActiveBlocksPerMultiprocessor(&per_cu, (const void*)fwd_megakernel, NT, LDS_BYTES) != hipSuccess || per_cu < 1) { fprintf(stderr, "kernel_launch: occupancy query reports %d workgroups per CU\n", per_cu); }
        (void)hipGetLastError();
        grid = cus;
    }
    if (grid < 0) return;
    if (hipMemsetAsync(ws + WS_CTL, 0, CTL_ZERO_BYTES, stream) != hipSuccess) { fprintf(stderr, "kernel_launch: memset failed\n"); return; }
    hipLaunchKernelGGL(fwd_megakernel, dim3(grid), dim3(NT), LDS_BYTES, stream, p);
}
```
